# Optimizing an MI355X kernel written in HIP

```python
import jax, jax.numpy as jnp
from jax import lax
import numpy as np

D_MODEL = 2048
BATCH = 4
SEQ = 2048
DEPTH = 2
DEC_BATCH = 128
DEC_SEQ = 1
PAST_LEN = 16384
PAGE_SIZE = 128

D_MIX = D_MODEL
D_ML = D_MIX // 2
D_CM = D_MIX - D_ML
ML_HEADS = 4
ML_HD = D_ML // ML_HEADS
CM_GROUPS = 4
CM_GD = D_CM // CM_GROUPS
CM_CHUNK = 128
ML_CHUNK = 128
D_IN = 5 * D_ML + 2 * ML_HEADS + 3 * D_CM
EPS = 1e-6

kernel_name = 'hymba_mlstm_chunkmlp_decoder_step'


def rmsnorm(x, g):
    xf = x.astype(jnp.float32)
    y = xf * lax.rsqrt(jnp.mean(xf * xf, axis=-1, keepdims=True) + EPS)
    return (y * g.astype(jnp.float32)).astype(x.dtype)


def layernorm(x, g):
    xf = x.astype(jnp.float32)
    mu = jnp.mean(xf, axis=-1, keepdims=True)
    xc = xf - mu
    y = xc * lax.rsqrt(jnp.mean(xc * xc, axis=-1, keepdims=True) + EPS)
    return (y * g.astype(jnp.float32)).astype(x.dtype)


def mlstm_chunk(carry, inp):
    C, n, m = carry
    q, k, v, ig, lf = inp
    L = q.shape[2]
    b = jnp.cumsum(lf, axis=-1)
    causal = jnp.tril(jnp.ones((L, L), dtype=bool))
    D = jnp.where(causal, b[..., :, None] - b[..., None, :] + ig[..., None, :], -jnp.inf)
    a = b + m[..., None]
    mt = jnp.maximum(a, jnp.max(D, axis=-1))
    w_intra = jnp.exp(D - mt[..., None])
    w_inter = jnp.exp(a - mt)
    s = jnp.einsum('bhtd,bhsd->bhts', q, k) * w_intra
    num = w_inter[..., None] * jnp.einsum('bhvd,bhtd->bhtv', C, q) + jnp.einsum('bhts,bhsv->bhtv', s, v)
    den = w_inter * jnp.einsum('bhd,bhtd->bht', n, q) + jnp.sum(s, axis=-1)
    h = num / jnp.maximum(jnp.abs(den), jnp.exp(-mt))[..., None]
    m_new = mt[..., -1]
    g_end = jnp.exp(b[..., -1:] - b + ig - m_new[..., None])
    decay = jnp.exp(a[..., -1] - m_new)
    C_new = decay[..., None, None] * C + jnp.einsum('bhs,bhsv,bhsd->bhvd', g_end, v, k)
    n_new = decay[..., None] * n + jnp.einsum('bhs,bhsd->bhd', g_end, k)
    return (C_new, n_new, m_new), h


def mlstm(q, k, v, ig, lf, C0, n0, m0):
    B, T, H, d = q.shape
    L = min(ML_CHUNK, T)
    nc = T // L
    c4 = lambda t: t.reshape(B, nc, L, H, t.shape[-1]).transpose(1, 0, 3, 2, 4)
    c3 = lambda t: t.reshape(B, nc, L, H).transpose(1, 0, 3, 2)
    (C1, n1, m1), hs = lax.scan(mlstm_chunk, (C0, n0, m0), (c4(q), c4(k), c4(v), c3(ig), c3(lf)))
    h = hs.transpose(1, 0, 3, 2, 4).reshape(B, T, H, hs.shape[-1])
    return h, C1, n1, m1


def spatial_mix(v, w_s, b_s):
    B, T, G, dg = v.shape
    L = min(CM_CHUNK, T)
    nc = T // L
    w = jnp.where(jnp.tril(jnp.ones((L, L), dtype=bool)), w_s[:, :L, :L], 0)
    vc = v.reshape(B, nc, L, G, dg)
    out = jnp.einsum('gts,bcsgd->bctgd', w, vc) + b_s[:, :L].T[None, None, :, :, None]
    return out.reshape(B, T, G, dg)


def mixer_layer(x, c, C0, n0, m0, g_norm, w_ada, b_ada, w_in, b_igate, b_fgate, g_mh, g_cmv, w_s, b_s, w_out):
    B, T, _ = x.shape
    f32 = jnp.float32
    shift, scale, gate = jnp.split(jax.nn.silu(c) @ w_ada + b_ada, 3, axis=-1)
    h = rmsnorm(x, g_norm) * (1 + scale[:, None, :]) + shift[:, None, :]
    p = h @ w_in
    sizes = [D_ML] * 5 + [ML_HEADS] * 2 + [D_CM] * 3
    offs = [int(o) for o in np.cumsum(sizes)[:-1]]
    q, k, v, o, z_ml, i_pre, f_pre, u, v_cm, z_cm = jnp.split(p, offs, axis=-1)
    heads = lambda t: t.reshape(B, T, ML_HEADS, ML_HD)
    ig = (i_pre + b_igate).astype(f32)
    lf = jax.nn.log_sigmoid((f_pre + b_fgate).astype(f32))
    h_ml, C1, n1, m1 = mlstm(heads(q).astype(f32), heads(k).astype(f32) * (ML_HD ** -0.5),
                             heads(v).astype(f32), ig, lf,
                             C0.astype(f32), n0.astype(f32), m0.astype(f32))
    h_ml = jax.nn.sigmoid(heads(o)) * h_ml.astype(x.dtype)
    h_ml = rmsnorm(h_ml, g_mh.reshape(ML_HEADS, ML_HD)).reshape(B, T, D_ML) * jax.nn.silu(z_ml)
    u = jax.nn.gelu(u)
    v_n = layernorm(jax.nn.gelu(v_cm).reshape(B, T, CM_GROUPS, CM_GD), g_cmv.reshape(CM_GROUPS, CM_GD))
    h_cm = u * spatial_mix(v_n, w_s, b_s).reshape(B, T, D_CM) * jax.nn.silu(z_cm)
    out = jnp.concatenate([h_ml, h_cm], axis=-1) @ w_out
    x = x + gate[:, None, :] * out
    return x, C1, n1, m1, v_n.reshape(B, T, D_CM)


def setup_inputs(seed: int = 0) -> dict:
    key = jax.random.key(seed)
    ks = jax.random.split(key, 24)
    nrm = jax.random.normal
    f32 = jnp.float32
    b_f = jnp.linspace(3.0, 6.0, ML_HEADS, dtype=f32)[None, :] + 0.1 * nrm(ks[12], (DEPTH, ML_HEADS), f32)
    return {
        'x_prompt': nrm(ks[0], (BATCH, SEQ, D_MODEL), f32),
        'x_sample': nrm(ks[1], (DEC_BATCH, DEC_SEQ, D_MODEL), f32),
        'state_C': 0.02 * nrm(ks[2], (DEPTH, DEC_BATCH, ML_HEADS, ML_HD, ML_HD), f32),
        'state_n': 0.02 * nrm(ks[3], (DEPTH, DEC_BATCH, ML_HEADS, ML_HD), f32),
        'state_m': jax.random.uniform(ks[4], (DEPTH, DEC_BATCH, ML_HEADS), f32, 0.0, 2.0),
        'c_prompt': nrm(ks[5], (BATCH, D_MODEL), f32),
        'c_sample': nrm(ks[6], (DEC_BATCH, D_MODEL), f32),
        'g_norm': 1.0 + 0.02 * nrm(ks[7], (DEPTH, D_MODEL), f32),
        'w_ada': 0.5 * D_MODEL ** -0.5 * nrm(ks[8], (DEPTH, D_MODEL, 3 * D_MODEL), f32),
        'b_ada': 0.02 * nrm(ks[9], (DEPTH, 3 * D_MODEL), f32),
        'w_in': D_MODEL ** -0.5 * nrm(ks[10], (DEPTH, D_MODEL, D_IN), f32),
        'b_igate': 0.1 * nrm(ks[11], (DEPTH, ML_HEADS), f32),
        'b_fgate': b_f,
        'g_mh': 1.0 + 0.02 * nrm(ks[13], (DEPTH, D_ML), f32),
        'g_cmv': 1.0 + 0.02 * nrm(ks[14], (DEPTH, D_CM), f32),
        'w_s': CM_CHUNK ** -0.5 * nrm(ks[15], (DEPTH, CM_GROUPS, CM_CHUNK, CM_CHUNK), f32),
        'b_s': 1.0 + 0.1 * nrm(ks[16], (DEPTH, CM_GROUPS, CM_CHUNK), f32),
        'w_out': D_MIX ** -0.5 * nrm(ks[17], (DEPTH, D_MIX, D_MODEL), f32),
        'g_final': 1.0 + 0.02 * nrm(ks[18], (D_MODEL,), f32),
    }


def reference(x_prompt, x_sample, state_C, state_n, state_m, c_prompt, c_sample,
              g_norm, w_ada, b_ada, w_in, b_igate, b_fgate, g_mh, g_cmv, w_s, b_s, w_out, g_final):
    f32 = jnp.float32
    zC = jnp.zeros((BATCH, ML_HEADS, ML_HD, ML_HD), f32)
    zn = jnp.zeros((BATCH, ML_HEADS, ML_HD), f32)
    zm = jnp.zeros((BATCH, ML_HEADS), f32)
    yp, ys = x_prompt, x_sample
    Cp_l, np_l, mp_l, Cs_l, ns_l, ms_l, vs_l = [], [], [], [], [], [], []
    for l in range(DEPTH):
        lp = (g_norm[l], w_ada[l], b_ada[l], w_in[l], b_igate[l], b_fgate[l],
              g_mh[l], g_cmv[l], w_s[l], b_s[l], w_out[l])
        yp, Cp, np_, mp, _ = mixer_layer(yp, c_prompt, zC, zn, zm, *lp)
        ys, Cs, ns, ms, vs = mixer_layer(ys, c_sample, state_C[l], state_n[l], state_m[l], *lp)
        Cp_l.append(Cp); np_l.append(np_); mp_l.append(mp)
        Cs_l.append(Cs); ns_l.append(ns); ms_l.append(ms); vs_l.append(vs)
    y_prompt = rmsnorm(yp, g_final)
    y_sample = rmsnorm(ys, g_final)
    return (y_prompt, y_sample,
            jnp.stack(Cp_l), jnp.stack(np_l), jnp.stack(mp_l),
            jnp.stack(Cs_l), jnp.stack(ns_l), jnp.stack(ms_l), jnp.stack(vs_l))
```

```cpp
#include <hip/hip_runtime.h>
#include <hip/hip_cooperative_groups.h>
#include <cstdio>
namespace cg = cooperative_groups;

#define LAS __attribute__((address_space(3)))
typedef unsigned short bf16_t;
typedef short bf16x8 __attribute__((ext_vector_type(8)));
typedef short s16x4 __attribute__((ext_vector_type(4)));
typedef float f32x4 __attribute__((ext_vector_type(4)));
typedef float f32x16 __attribute__((ext_vector_type(16)));
typedef unsigned u32x4 __attribute__((ext_vector_type(4)));
typedef unsigned u32x2 __attribute__((ext_vector_type(2)));

constexpr int D = 2048, MP = 8192, MS = 128, MT = 8320, MPAD = 8448;
constexpr int NB = 8192, DIN = 8200, NMOD = 6144, NCR = 132;
constexpr float EPS = 1e-6f;
constexpr size_t OY = 0, OCP = 17039360, ONP = 19136512, OMP = 19144704, OCS = 19144736, ONS = 86253600, OMS = 86515744, OVS = 86516768;
constexpr size_t MiB = 1u << 20;
constexpr size_t WS_WIN = 1 * MiB;
constexpr size_t WS_WOUT = 65 * MiB;
constexpr size_t WS_SC = 81 * MiB;
constexpr size_t WS_MOD = 82 * MiB;
constexpr size_t WS_HN = 90 * MiB;
constexpr size_t WS_P = 123 * MiB;
constexpr size_t WS_IG = 255 * MiB;
constexpr size_t WS_LF = 255 * MiB + 512 * 1024;
constexpr size_t WS_X1 = 256 * MiB;
constexpr size_t WS_ACT = 321 * MiB;
constexpr size_t WS_CST = 354 * MiB;
constexpr size_t WS_NST = 386 * MiB;
constexpr size_t WS_MST = 386 * MiB + 512 * 1024;
constexpr size_t WS_END = 387 * MiB;
constexpr int LDS_BYTES = 155648;
constexpr int NPHASE = 13;

struct Args { const float* in[19]; float* out; unsigned char* ws; int ph_lo, ph_hi; };

__device__ __forceinline__ float bf2f(bf16_t b) { return __uint_as_float(((unsigned)b) << 16); }
__device__ __forceinline__ float bflo(unsigned w) { return __uint_as_float(w << 16); }
__device__ __forceinline__ float bfhi(unsigned w) { return __uint_as_float(w & 0xffff0000u); }
__device__ __forceinline__ unsigned cvt_pk_bf16(float lo, float hi) { unsigned r; asm volatile("v_cvt_pk_bf16_f32 %0, %1, %2" : "=v"(r) : "v"(lo), "v"(hi)); return r; }
__device__ __forceinline__ bf16_t f2bf(float f) { return (bf16_t)(cvt_pk_bf16(f, 0.f) & 0xffffu); }
__device__ __forceinline__ float sigmoidf_(float x) { return 1.0f / (1.0f + __expf(-x)); }
__device__ __forceinline__ float siluf_(float x) { return x / (1.0f + __expf(-x)); }
__device__ __forceinline__ float geluf_(float x) { const float u = 1.5957691216f * (x + 0.044715f * x * x * x); return x / (1.0f + __expf(-u)); }
__device__ __forceinline__ float wave_sum(float v) {
#pragma unroll
    for (int o = 1; o < 64; o <<= 1) v += __shfl_xor(v, o);
    return v;
}
__device__ __forceinline__ int rowof(int reg, int hh) { return (reg & 3) + 8 * (reg >> 2) + 4 * hh; }
__device__ __forceinline__ bf16x8 frag_row(const LAS unsigned char* base, int ldb, int row0, int k0, int lane) {
    return *(const LAS bf16x8*)(base + (row0 + (lane & 31)) * ldb + (k0 + 8 * (lane >> 5)) * 2);
}
__device__ __forceinline__ bf16x8 frag_tr(const LAS unsigned char* base, int ldb, int k0, int n0, int lane) {
    const int hh = lane >> 5, blk = (lane >> 4) & 1, q = (lane & 15) >> 2, p = lane & 3;
    const LAS unsigned char* a = base + (k0 + 8 * hh + q) * ldb + (n0 + 16 * blk + 4 * p) * 2;
    const s16x4 lo = __builtin_amdgcn_ds_read_tr16_b64_v4i16((LAS s16x4*)a);
    const s16x4 hi = __builtin_amdgcn_ds_read_tr16_b64_v4i16((LAS s16x4*)(a + 4 * ldb));
    return (bf16x8){lo[0], lo[1], lo[2], lo[3], hi[0], hi[1], hi[2], hi[3]};
}
__device__ __forceinline__ f32x16 mma32(bf16x8 a, bf16x8 b, f32x16 c) { return __builtin_amdgcn_mfma_f32_32x32x16_bf16(a, b, c, 0, 0, 0); }
__device__ __forceinline__ f32x16 zero16() { f32x16 z;
#pragma unroll
    for (int i = 0; i < 16; ++i) z[i] = 0.f;
    return z; }

namespace pg8 {
constexpr int BM = 256, BK = 64, HALF = 128, HTB = HALF * BK * 2, STAGE_BYTES = 8 * HTB, NXCD = 8, WGM = 8;
__device__ __forceinline__ int lds_byte(int r, int c) { const int st = (r >> 4) * 2 + (c >> 5), rr = r & 15, cc = c & 31, ob = rr * 64 + cc * 2; return st * 1024 + (ob ^ (((ob >> 9) & 1) << 5)); }
__device__ __forceinline__ void stage_rc(int b, int& R, int& C) { const int st = b / 1024, sb = b % 1024, swz = sb ^ (((sb >> 9) & 1) << 5); R = (st >> 1) * 16 + swz / 64; C = (st & 1) * 32 + (swz % 64) / 2; }
__device__ __forceinline__ int perm32(int rho) { const int n = rho >> 4, i = rho & 15; return 8 * (i >> 2) + 4 * n + (i & 3); }
struct Unit { int pm, pn; };
struct Gemm { const bf16_t* A; const bf16_t* Bt; int M, N, K; };
struct StaticOrder {
    int nM, nN, nwg, G, c;
    __device__ void init(int M, int N, int G_, int c_) { nM = M / BM; nN = N / BM; nwg = nM * nN; G = G_; c = c_; }
    __device__ bool next(int i, Unit& u) const {
        const long L = (long)i * G + c; if (L >= nwg) return false;
        int wgid = (int)L; { const int q = nwg / NXCD, r = nwg % NXCD, xcd = wgid % NXCD, off = wgid / NXCD; wgid = (xcd < r ? xcd * (q + 1) : r * (q + 1) + (xcd - r) * q) + off; }
        const int nig = WGM * nN, gid = wgid / nig, fm = gid * WGM, gsz = (nM - fm) < WGM ? (nM - fm) : WGM;
        u.pm = fm + ((wgid % nig) % gsz); u.pn = (wgid % nig) / gsz; return true;
    }
};
struct EpiP {
    static constexpr bool PERM = true;
    bf16_t* O; int ldc;
    __device__ __forceinline__ void operator()(const f32x4 (&acc)[2][2][4][2], const Unit& u, int wr, int wc, int fr, int fq) const {
        const int row0 = u.pm * BM + wr * 64 + fr, col0 = u.pn * BM + wc * 32 + 8 * fq;
#pragma unroll
        for (int ai = 0; ai < 2; ++ai)
#pragma unroll
            for (int m = 0; m < 4; ++m) { bf16_t* rowp = O + (size_t)(row0 + ai * HALF + m * 16) * ldc + col0;
#pragma unroll
                for (int bj = 0; bj < 2; ++bj) { const f32x4 v0 = acc[ai][bj][m][0], v1 = acc[ai][bj][m][1];
                    u32x4 w; w.x = cvt_pk_bf16(v0[0], v0[1]); w.y = cvt_pk_bf16(v0[2], v0[3]); w.z = cvt_pk_bf16(v1[0], v1[1]); w.w = cvt_pk_bf16(v1[2], v1[3]);
                    *(u32x4*)(rowp + bj * HALF) = w; } }
    }
};
struct EpiRes {
    static constexpr bool PERM = false;
    const float* xp; const float* xs; float* dst; const float* mod;
    __device__ __forceinline__ void operator()(const f32x4 (&acc)[2][2][4][2], const Unit& u, int wr, int wc, int fr, int fq) const {
        const int row0 = u.pm * BM + wr * 64 + fr, col0 = u.pn * BM + wc * 32 + 4 * fq;
#pragma unroll
        for (int ai = 0; ai < 2; ++ai)
#pragma unroll
            for (int m = 0; m < 4; ++m) { const int r = row0 + ai * HALF + m * 16;
                if (r < MT) {
                    const int mrow = r < MP ? (r >> 11) : 4 + (r - MP);
                    const float* xo = (r < MP ? xp + (size_t)r * D : xs + (size_t)(r - MP) * D) + col0;
                    const float* gp = mod + (size_t)mrow * NMOD + 4096 + col0;
                    float* dp = dst + (size_t)r * D + col0;
#pragma unroll
                    for (int bj = 0; bj < 2; ++bj)
#pragma unroll
                        for (int n = 0; n < 2; ++n) { const f32x4 g = *(const f32x4*)(gp + bj * HALF + n * 16); const f32x4 x = *(const f32x4*)(xo + bj * HALF + n * 16);
                            *(f32x4*)(dp + bj * HALF + n * 16) = x + g * acc[ai][bj][m][n]; } } }
    }
};

template <class Epi, class Sched>
__device__ __forceinline__ void gemm_phase(LAS unsigned char* lds, const Gemm g, const Sched& S, const Epi& E) {
    int tid = threadIdx.x; asm volatile("" : "+v"(tid));
    const int wid = __builtin_amdgcn_readfirstlane(tid >> 6), lane = tid & 63, wr = wid >> 2, wc = wid & 3, fr = lane & 15, fq = lane >> 4;
    const int K = g.K, nt = K / BK;
    unsigned voffA[2], voffB[2];
#pragma unroll
    for (int i = 0; i < 2; ++i) { int R, C; stage_rc(tid * 16 + i * 8192, R, C); const int Rb = Epi::PERM ? ((R & ~31) + perm32(R & 31)) : R;
        voffA[i] = (unsigned)(R * K + C) * 2u; voffB[i] = (unsigned)(Rb * K + C) * 2u; }
    const size_t kstep = (size_t)(BK * 2);
    const size_t hstep = (size_t)HALF * K * 2;
    const size_t tstep = 2 * hstep;
    const unsigned ldsw = (unsigned)wid * 1024u;
    const int aoff = lds_byte(wr * 64 + fr, fq * 8), boff = lds_byte(wc * 32 + fr, fq * 8);
#define PG8_SA(b, h) (((b) * 2 + (h)) * HTB)
#define PG8_SB(b, h) ((4 + (b) * 2 + (h)) * HTB)
#define PG8_STAGE(bufoff, gbase, voff) do { _Pragma("unroll") for (int _i = 0; _i < 2; ++_i) \
        __builtin_amdgcn_global_load_lds((const unsigned*)((const char*)(gbase) + (voff)[_i]), (LAS unsigned*)(lds + (bufoff) + ldsw + _i * 8192), 16, 0, 0); } while (0)
#define PG8_LDA(dst, b, h) do { _Pragma("unroll") for (int m = 0; m < 4; ++m) _Pragma("unroll") for (int k = 0; k < 2; ++k) dst[m][k] = *(const LAS bf16x8*)(lds + PG8_SA(b, h) + aoff + m * 2048 + k * 1024); } while (0)
#define PG8_LDB(dst, b, h) do { _Pragma("unroll") for (int n = 0; n < 2; ++n) _Pragma("unroll") for (int k = 0; k < 2; ++k) dst[n][k] = *(const LAS bf16x8*)(lds + PG8_SB(b, h) + boff + n * 2048 + k * 1024); } while (0)
#define PG8_MMA(ai, bj, At, Bt) do { __builtin_amdgcn_s_setprio(1); _Pragma("unroll") for (int m = 0; m < 4; ++m) _Pragma("unroll") for (int n = 0; n < 2; ++n) _Pragma("unroll") for (int k = 0; k < 2; ++k) \
        acc[ai][bj][m][n] = __builtin_amdgcn_mfma_f32_16x16x32_bf16(Bt[n][k], At[m][k], acc[ai][bj][m][n], 0, 0, 0); __builtin_amdgcn_s_setprio(0); } while (0)
#define PG8_WAIT_V(n) asm volatile("s_waitcnt vmcnt(" #n ")" ::: "memory")
#define PG8_WAIT_L(n) asm volatile("s_waitcnt lgkmcnt(" #n ")" ::: "memory")
#define PG8_BAR __builtin_amdgcn_s_barrier()
#define PG8_SCHED __builtin_amdgcn_sched_barrier(0)
    Unit cur, nxt; int ui = 0;
    if (!S.next(0, cur)) return;
    f32x4 acc[2][2][4][2];
#pragma unroll
    for (int a = 0; a < 2; ++a)
#pragma unroll
        for (int b = 0; b < 2; ++b)
#pragma unroll
            for (int m = 0; m < 4; ++m)
#pragma unroll
                for (int n = 0; n < 2; ++n) acc[a][b][m][n] = (f32x4){0.f, 0.f, 0.f, 0.f};
    bf16x8 At[4][2], B0[2][2], B1[2][2];
    const char* cA = (const char*)g.A + (size_t)cur.pm * tstep; const char* cB = (const char*)g.Bt + (size_t)cur.pn * tstep;
    PG8_STAGE(PG8_SB(0, 0), cB, voffB); PG8_STAGE(PG8_SA(0, 0), cA, voffA); PG8_STAGE(PG8_SB(0, 1), cB + hstep, voffB); PG8_STAGE(PG8_SA(0, 1), cA + hstep, voffA);
    if (wr == 1) PG8_BAR;
    PG8_WAIT_V(4); PG8_BAR;
    PG8_STAGE(PG8_SB(1, 0), cB + kstep, voffB); PG8_STAGE(PG8_SA(1, 0), cA + kstep, voffA); PG8_STAGE(PG8_SB(1, 1), cB + hstep + kstep, voffB);
    PG8_WAIT_V(6); PG8_BAR;
    for (;;) {
        const bool has_next = S.next(ui + 1, nxt);
        const char* nA = has_next ? (const char*)g.A + (size_t)nxt.pm * tstep : cA; const char* nB = has_next ? (const char*)g.Bt + (size_t)nxt.pn * tstep : cB;
        for (int t = 0; t < nt; t += 2) {
            const bool last = (t == nt - 2);
            const char* a1 = cA + (size_t)(t + 1) * kstep;
            const char* a2 = last ? nA : cA + (size_t)(t + 2) * kstep; const char* b2 = last ? nB : cB + (size_t)(t + 2) * kstep;
            const char* a3 = a2 + kstep; const char* b3 = b2 + kstep;
            PG8_LDB(B0, 0, 0); PG8_SCHED; PG8_LDA(At, 0, 0); PG8_STAGE(PG8_SA(1, 1), a1 + hstep, voffA);
            PG8_WAIT_L(8); PG8_BAR; PG8_WAIT_L(0); PG8_MMA(0, 0, At, B0); PG8_BAR; PG8_SCHED;
            PG8_LDB(B1, 0, 1); PG8_STAGE(PG8_SB(0, 0), b2, voffB);
            PG8_BAR; PG8_WAIT_L(0); PG8_MMA(0, 1, At, B1); PG8_BAR;
            PG8_LDA(At, 0, 1); PG8_STAGE(PG8_SA(0, 0), a2, voffA);
            PG8_BAR; PG8_WAIT_L(0); PG8_MMA(1, 0, At, B0); PG8_BAR; PG8_SCHED;
            PG8_STAGE(PG8_SB(0, 1), b2 + hstep, voffB);
            PG8_WAIT_V(6); PG8_BAR; PG8_MMA(1, 1, At, B1); PG8_BAR;
            PG8_LDB(B0, 1, 0); PG8_SCHED; PG8_LDA(At, 1, 0); PG8_STAGE(PG8_SA(0, 1), a2 + hstep, voffA);
            PG8_WAIT_L(8); PG8_BAR; PG8_WAIT_L(0); PG8_MMA(0, 0, At, B0); PG8_BAR; PG8_SCHED;
            PG8_LDB(B1, 1, 1); PG8_STAGE(PG8_SB(1, 0), b3, voffB);
            PG8_BAR; PG8_WAIT_L(0); PG8_MMA(0, 1, At, B1); PG8_BAR;
            PG8_LDA(At, 1, 1); PG8_STAGE(PG8_SA(1, 0), a3, voffA);
            PG8_BAR; PG8_WAIT_L(0); PG8_MMA(1, 0, At, B0); PG8_BAR; PG8_SCHED;
            PG8_STAGE(PG8_SB(1, 1), b3 + hstep, voffB);
            PG8_WAIT_V(6); PG8_BAR; PG8_MMA(1, 1, At, B1); PG8_BAR;
        }
        E(acc, cur, wr, wc, fr, fq);
        if (!has_next) break;
#pragma unroll
        for (int a = 0; a < 2; ++a)
#pragma unroll
            for (int b = 0; b < 2; ++b)
#pragma unroll
                for (int m = 0; m < 4; ++m)
#pragma unroll
                    for (int n = 0; n < 2; ++n) acc[a][b][m][n] = (f32x4){0.f, 0.f, 0.f, 0.f};
        cur = nxt; cA = nA; cB = nB; ++ui;
    }
    PG8_WAIT_V(0);
    if (wr == 0) PG8_BAR;
    PG8_BAR;
#undef PG8_SA
#undef PG8_SB
#undef PG8_STAGE
#undef PG8_LDA
#undef PG8_LDB
#undef PG8_MMA
#undef PG8_WAIT_V
#undef PG8_WAIT_L
#undef PG8_BAR
#undef PG8_SCHED
}
}

__device__ __forceinline__ void transpose_item(const float* W, int ldw, int nblk, bf16_t* WT, int K, int item, bool remap, LAS float* scr, int lane) {
    const int kb = item / nblk, nb = item % nblk, k0 = 64 * kb, n0 = 32 * nb;
    const int n0s = (remap && n0 >= 5120) ? n0 + 8 : n0;
#pragma unroll 8
    for (int i = 0; i < 32; ++i) { const int kk = 2 * i + (lane >> 5); scr[kk * 33 + (lane & 31)] = W[(size_t)(k0 + kk) * ldw + n0s + (lane & 31)]; }
    asm volatile("s_waitcnt lgkmcnt(0)" ::: "memory");
    const int c = lane & 7;
#pragma unroll
    for (int j = 0; j < 4; ++j) { const int n = (lane >> 3) + 8 * j; const LAS float* s = scr + (8 * c) * 33 + n;
        u32x4 o; o.x = cvt_pk_bf16(s[0 * 33], s[1 * 33]); o.y = cvt_pk_bf16(s[2 * 33], s[3 * 33]); o.z = cvt_pk_bf16(s[4 * 33], s[5 * 33]); o.w = cvt_pk_bf16(s[6 * 33], s[7 * 33]);
        *(u32x4*)(WT + (size_t)(n0 + n) * K + k0 + 8 * c) = o; }
    asm volatile("s_waitcnt lgkmcnt(0)" ::: "memory");
}
__device__ __forceinline__ void phase0(const Args& a, LAS unsigned char* lds, int tid, int lane, int wave, int G, int bid) {
    bf16_t* SC = (bf16_t*)(a.ws + WS_SC);
    const float* cp = a.in[5]; const float* cs = a.in[6];
    for (int i = bid * 512 + tid; i < 160 * 512; i += G * 512) {
        const int r = i >> 9, c4 = (i & 511) * 4;
        f32x4 v = (f32x4){0.f, 0.f, 0.f, 0.f};
        if (r < 4) v = *(const f32x4*)(cp + (size_t)r * D + c4); else if (r < NCR) v = *(const f32x4*)(cs + (size_t)(r - 4) * D + c4);
        u32x2 o; o.x = cvt_pk_bf16(siluf_(v[0]), siluf_(v[1])); o.y = cvt_pk_bf16(siluf_(v[2]), siluf_(v[3]));
        *(u32x2*)(SC + (size_t)r * D + c4) = o;
    }
    LAS float* scr = (LAS float*)(lds + wave * 8448);
    const int gw = bid * 8 + wave, NGW = G * 8;
    constexpr int I_IN = 32 * 256, I_OUT = 32 * 64;
    for (int it = gw; it < 2 * I_IN + 2 * I_OUT; it += NGW) {
        if (it < 2 * I_IN) { const int l = it / I_IN, r = it % I_IN;
            transpose_item(a.in[10] + (size_t)l * D * DIN, DIN, 256, (bf16_t*)(a.ws + WS_WIN) + (size_t)l * NB * D, D, r, true, scr, lane); }
        else { const int j = it - 2 * I_IN, l = j / I_OUT, r = j % I_OUT;
            transpose_item(a.in[17] + (size_t)l * D * D, D, 64, (bf16_t*)(a.ws + WS_WOUT) + (size_t)l * D * D, D, r, false, scr, lane); }
    }
}

__device__ __forceinline__ void phase_ada(const Args& a, LAS unsigned char* lds, int tid, int lane, int wave, int G, int bid) {
    const bf16_t* SC = (const bf16_t*)(a.ws + WS_SC);
    float* MOD = (float*)(a.ws + WS_MOD);
    LAS float* red = (LAS float*)lds;
    const int r = lane & 31, hh = lane >> 5;
    for (int item = bid; item < 384; item += G) {
        const int l = item / 192, n0 = (item % 192) * 32;
        const float* W = a.in[8] + (size_t)l * D * NMOD;
        const int kbase = wave * 256;
        f32x16 acc[5];
#pragma unroll
        for (int i = 0; i < 5; ++i) acc[i] = zero16();
#pragma unroll 2
        for (int ks = 0; ks < 16; ++ks) {
            const int k0 = kbase + ks * 16;
            const float* wp = W + (size_t)(k0 + 8 * hh) * NMOD + n0 + r;
            float wv[8];
#pragma unroll
            for (int j = 0; j < 8; ++j) wv[j] = wp[(size_t)j * NMOD];
            union { u32x4 u; bf16x8 v; } bfr;
            bfr.u.x = cvt_pk_bf16(wv[0], wv[1]); bfr.u.y = cvt_pk_bf16(wv[2], wv[3]); bfr.u.z = cvt_pk_bf16(wv[4], wv[5]); bfr.u.w = cvt_pk_bf16(wv[6], wv[7]);
#pragma unroll
            for (int rb = 0; rb < 5; ++rb) { const bf16x8 af = *(const bf16x8*)(SC + (size_t)(rb * 32 + r) * D + k0 + 8 * hh); acc[rb] = mma32(af, bfr.v, acc[rb]); }
        }
#pragma unroll
        for (int rb = 0; rb < 5; ++rb) {
#pragma unroll
            for (int reg = 0; reg < 16; ++reg) red[wave * 1024 + reg * 64 + lane] = acc[rb][reg];
            __syncthreads();
#pragma unroll
            for (int e2 = 0; e2 < 2; ++e2) { const int e = tid + e2 * 512; float s = 0.f;
#pragma unroll
                for (int w = 0; w < 8; ++w) s += red[w * 1024 + e];
                const int reg = e >> 6, ln = e & 63; const int row = rb * 32 + rowof(reg, ln >> 5), col = n0 + (ln & 31);
                if (row < NCR) MOD[((size_t)l * NCR + row) * NMOD + col] = s + a.in[9][(size_t)l * NMOD + col]; }
            __syncthreads();
        }
    }
}

__device__ __forceinline__ void phase_norm(const Args& a, int l, LAS unsigned char* lds, int tid, int lane, int wave, int G, int bid) {
    LAS float* Wg = (LAS float*)lds;
    const float* win = a.in[10] + (size_t)l * D * DIN;
    for (int k = tid; k < D; k += 512) { const f32x4 w0 = *(const f32x4*)(win + (size_t)k * DIN + 5120), w1 = *(const f32x4*)(win + (size_t)k * DIN + 5124);
        Wg[0 * D + k] = w0[0]; Wg[1 * D + k] = w0[1]; Wg[2 * D + k] = w0[2]; Wg[3 * D + k] = w0[3];
        Wg[4 * D + k] = w1[0]; Wg[5 * D + k] = w1[1]; Wg[6 * D + k] = w1[2]; Wg[7 * D + k] = w1[3]; }
    __syncthreads();
    const float* xp = l == 0 ? a.in[0] : (const float*)(a.ws + WS_X1);
    const float* xs = l == 0 ? a.in[1] : (const float*)(a.ws + WS_X1) + (size_t)MP * D;
    const float* gn = a.in[7] + (size_t)l * D;
    const float* MOD = (const float*)(a.ws + WS_MOD) + (size_t)l * NCR * NMOD;
    bf16_t* HN = (bf16_t*)(a.ws + WS_HN);
    float* IG = (float*)(a.ws + WS_IG); float* LF = (float*)(a.ws + WS_LF);
    for (int r = bid * 8 + wave; r < MT; r += G * 8) {
        const float* xr = (r < MP ? xp + (size_t)r * D : xs + (size_t)(r - MP) * D) + lane * 4;
        const int mrow = r < MP ? (r >> 11) : 4 + (r - MP);
        const float* mp = MOD + (size_t)mrow * NMOD + lane * 4;
        f32x4 v[8]; float ss = 0.f;
#pragma unroll
        for (int i = 0; i < 8; ++i) { v[i] = *(const f32x4*)(xr + 256 * i); ss += (v[i][0] * v[i][0] + v[i][1] * v[i][1]) + (v[i][2] * v[i][2] + v[i][3] * v[i][3]); }
        const float rstd = rsqrtf(wave_sum(ss) * (1.0f / D) + EPS);
        float gd[8];
#pragma unroll
        for (int j = 0; j < 8; ++j) gd[j] = 0.f;
#pragma unroll
        for (int i = 0; i < 8; ++i) {
            const f32x4 g = *(const f32x4*)(gn + lane * 4 + 256 * i), sh = *(const f32x4*)(mp + 256 * i), sc = *(const f32x4*)(mp + 2048 + 256 * i);
            const f32x4 hv = v[i] * rstd * g * (sc + 1.0f) + sh;
            u32x2 o; o.x = cvt_pk_bf16(hv[0], hv[1]); o.y = cvt_pk_bf16(hv[2], hv[3]);
            *(u32x2*)(HN + (size_t)r * D + lane * 4 + 256 * i) = o;
#pragma unroll
            for (int j = 0; j < 8; ++j) { const f32x4 w = *(const LAS f32x4*)(Wg + j * D + lane * 4 + 256 * i); gd[j] += (hv[0] * w[0] + hv[1] * w[1]) + (hv[2] * w[2] + hv[3] * w[3]); }
        }
#pragma unroll
        for (int j = 0; j < 8; ++j) gd[j] = wave_sum(gd[j]);
        if (lane < 4) {
            const float gi = lane == 0 ? gd[0] : lane == 1 ? gd[1] : lane == 2 ? gd[2] : gd[3];
            const float gf = lane == 0 ? gd[4] : lane == 1 ? gd[5] : lane == 2 ? gd[6] : gd[7];
            IG[r * 4 + lane] = gi + a.in[11][l * 4 + lane];
            const float f = gf + a.in[12][l * 4 + lane];
            LF[r * 4 + lane] = fminf(f, 0.f) - log1pf(expf(-fabsf(f)));
        }
    }
    __syncthreads();
}

__device__ __forceinline__ void chunk_scan(const float* IG, const float* LF, int r0, int h, int lane, float& b0, float& b1, float& e0, float& e1, float& cm0, float& cm1) {
    const float lf0 = LF[(r0 + 2 * lane) * 4 + h], lf1 = LF[(r0 + 2 * lane + 1) * 4 + h];
    const float ig0 = IG[(r0 + 2 * lane) * 4 + h], ig1 = IG[(r0 + 2 * lane + 1) * 4 + h];
    float s = lf0 + lf1;
#pragma unroll
    for (int o = 1; o < 64; o <<= 1) { const float t = __shfl_up(s, o); if (lane >= o) s += t; }
    b1 = s; b0 = s - lf1;
    e0 = ig0 - b0; e1 = ig1 - b1;
    float mx = fmaxf(e0, e1);
#pragma unroll
    for (int o = 1; o < 64; o <<= 1) { const float t = __shfl_up(mx, o); if (lane >= o) mx = fmaxf(mx, t); }
    cm1 = mx;
    const float prev = __shfl_up(mx, 1);
    cm0 = lane > 0 ? fmaxf(prev, e0) : e0;
}

__device__ __forceinline__ void scan_item(const Args& a, int l, int item, LAS unsigned char* lds, int tid, int lane, int wave) {
    const int bh = item >> 3, vt = (item >> 2) & 1, dt = item & 3, b = bh >> 2, h = bh & 3;
    LAS unsigned char* Vt = lds;
    LAS unsigned char* Kt = lds + 34816;
    LAS float* E = (LAS float*)(lds + 53248);
    LAS float* Gs = E + 2048;
    LAS float* Bc = Gs + 2048; LAS float* CMX = Bc + 16; LAS float* MC = CMX + 16; LAS float* DEC = MC + 32;
    const float* IG = (const float*)(a.ws + WS_IG); const float* LF = (const float*)(a.ws + WS_LF);
    const bf16_t* P = (const bf16_t*)(a.ws + WS_P);
    bf16_t* CST = (bf16_t*)(a.ws + WS_CST); float* NST = (float*)(a.ws + WS_NST); float* MST = (float*)(a.ws + WS_MST);
#pragma unroll
    for (int j = 0; j < 2; ++j) { const int cc = 2 * wave + j; float b0, b1, e0, e1, cm0, cm1;
        chunk_scan(IG, LF, b * 2048 + cc * 128, h, lane, b0, b1, e0, e1, cm0, cm1);
        E[cc * 128 + 2 * lane] = e0; E[cc * 128 + 2 * lane + 1] = e1;
        if (lane == 63) { Bc[cc] = b1; CMX[cc] = cm1; } }
    __syncthreads();
    if (tid == 0) { float m = 0.f;
        for (int cc = 0; cc < 16; ++cc) { MC[cc] = m; const float mn = Bc[cc] + fmaxf(m, CMX[cc]); DEC[cc] = __expf(Bc[cc] + m - mn); m = mn; }
        MC[16] = m; }
    __syncthreads();
    for (int t = tid; t < 2048; t += 512) { const int cc = t >> 7; Gs[t] = __expf(Bc[cc] + E[t] - MC[cc + 1]) * 0.0625f; }
    if (vt == 0 && dt == 0) { if (tid < 16) MST[bh * 16 + tid] = MC[tid]; if (tid == 0) a.out[OMP + l * 16 + bh] = MC[16]; }
    f32x16 acc = zero16(); float nacc = 0.f;
    const int vb = wave >> 1, db = wave & 1, r = lane & 31, hh = lane >> 5;
    const bool nown = (vt == 0 && tid < 64);
    for (int c = 0; c < 16; ++c) {
        const int r0 = b * 2048 + c * 128;
        { bf16_t* cp_ = CST + ((size_t)(bh * 16 + c) * 256 + vt * 128 + vb * 32 + r) * 256 + dt * 64 + db * 32 + 4 * hh;
#pragma unroll
          for (int q4 = 0; q4 < 4; ++q4) { u32x2 o; o.x = cvt_pk_bf16(acc[4 * q4 + 0], acc[4 * q4 + 1]); o.y = cvt_pk_bf16(acc[4 * q4 + 2], acc[4 * q4 + 3]); *(u32x2*)(cp_ + 8 * q4) = o; } }
        if (nown) NST[(bh * 16 + c) * 256 + dt * 64 + tid] = nacc;
        __syncthreads();
#pragma unroll
        for (int i2 = 0; i2 < 4; ++i2) { const int i = tid + i2 * 512, s = i >> 4, ch = i & 15;
            const u32x4 raw = *(const u32x4*)(P + (size_t)(r0 + s) * NB + 2048 + h * 256 + vt * 128 + ch * 8); const float g = Gs[c * 128 + s];
            u32x4 o; o.x = cvt_pk_bf16(bflo(raw.x) * g, bfhi(raw.x) * g); o.y = cvt_pk_bf16(bflo(raw.y) * g, bfhi(raw.y) * g);
            o.z = cvt_pk_bf16(bflo(raw.z) * g, bfhi(raw.z) * g); o.w = cvt_pk_bf16(bflo(raw.w) * g, bfhi(raw.w) * g);
            *(LAS u32x4*)(Vt + s * 272 + ch * 16) = o; }
#pragma unroll
        for (int i2 = 0; i2 < 2; ++i2) { const int i = tid + i2 * 512, s = i >> 3, ch = i & 7;
            *(LAS u32x4*)(Kt + s * 144 + ch * 16) = *(const u32x4*)(P + (size_t)(r0 + s) * NB + 1024 + h * 256 + dt * 64 + ch * 8); }
        __syncthreads();
        const float dec = DEC[c];
#pragma unroll
        for (int reg = 0; reg < 16; ++reg) acc[reg] *= dec;
#pragma unroll
        for (int ks = 0; ks < 8; ++ks) { const bf16x8 vf = frag_tr(Vt, 272, ks * 16, vb * 32, lane); const bf16x8 kf = frag_tr(Kt, 144, ks * 16, db * 32, lane); acc = mma32(kf, vf, acc); }
        if (nown) { float sum = 0.f;
            for (int s = 0; s < 128; ++s) sum += Gs[c * 128 + s] * bf2f(*(const LAS bf16_t*)(Kt + s * 144 + tid * 2));
            nacc = dec * nacc + sum; }
    }
    { float* op_ = a.out + OCP + ((size_t)(l * 16 + bh) * 256 + vt * 128 + vb * 32 + r) * 256 + dt * 64 + db * 32 + 4 * hh;
#pragma unroll
      for (int q4 = 0; q4 < 4; ++q4) *(f32x4*)(op_ + 8 * q4) = (f32x4){acc[4 * q4 + 0], acc[4 * q4 + 1], acc[4 * q4 + 2], acc[4 * q4 + 3]}; }
    if (nown) a.out[ONP + (l * 16 + bh) * 256 + dt * 64 + tid] = nacc;
    __syncthreads();
}

__device__ __forceinline__ void mix_item(const Args& a, int l, int item, LAS unsigned char* lds, int tid, int lane, int wave) {
    const int b = item >> 6, c = (item >> 2) & 15, g = item & 3, r0 = b * 2048 + c * 128;
    LAS unsigned char* VN = lds;
    LAS unsigned char* WW = lds + 67584;
    const bf16_t* P = (const bf16_t*)(a.ws + WS_P);
    bf16_t* ACT = (bf16_t*)(a.ws + WS_ACT);
    const float* ws_ = a.in[15] + (size_t)(l * 4 + g) * 128 * 128;
#pragma unroll
    for (int i2 = 0; i2 < 8; ++i2) { const int i = tid + i2 * 512, t = i >> 5, s4 = (i & 31) * 4;
        f32x4 w = *(const f32x4*)(ws_ + t * 128 + s4);
        if (s4 + 0 > t) w[0] = 0.f; if (s4 + 1 > t) w[1] = 0.f; if (s4 + 2 > t) w[2] = 0.f; if (s4 + 3 > t) w[3] = 0.f;
        u32x2 o; o.x = cvt_pk_bf16(w[0], w[1]); o.y = cvt_pk_bf16(w[2], w[3]);
        *(LAS u32x2*)(WW + t * 272 + s4 * 2) = o; }
    const f32x4 gc = *(const f32x4*)(a.in[14] + l * 1024 + g * 256 + lane * 4);
    for (int i = 0; i < 16; ++i) { const int s = wave * 16 + i;
        const u32x2 raw = *(const u32x2*)(P + (size_t)(r0 + s) * NB + 6144 + g * 256 + lane * 4);
        float x0 = geluf_(bflo(raw.x)), x1 = geluf_(bfhi(raw.x)), x2 = geluf_(bflo(raw.y)), x3 = geluf_(bfhi(raw.y));
        const float mean = wave_sum((x0 + x1) + (x2 + x3)) * (1.0f / 256.0f);
        x0 -= mean; x1 -= mean; x2 -= mean; x3 -= mean;
        const float rstd = rsqrtf(wave_sum((x0 * x0 + x1 * x1) + (x2 * x2 + x3 * x3)) * (1.0f / 256.0f) + EPS);
        u32x2 o; o.x = cvt_pk_bf16(x0 * rstd * gc[0], x1 * rstd * gc[1]); o.y = cvt_pk_bf16(x2 * rstd * gc[2], x3 * rstd * gc[3]);
        *(LAS u32x2*)(VN + s * 528 + lane * 8) = o; }
    __syncthreads();
    const int tb = wave >> 1, cb0 = (wave & 1) * 4, r = lane & 31, hh = lane >> 5;
    f32x16 acc[4];
#pragma unroll
    for (int j = 0; j < 4; ++j) acc[j] = zero16();
    for (int ks = 0; ks < 2 * (tb + 1); ++ks) { const bf16x8 wf = frag_row(WW, 272, tb * 32, ks * 16, lane);
#pragma unroll
        for (int j = 0; j < 4; ++j) { const bf16x8 vf = frag_tr(VN, 528, ks * 16, (cb0 + j) * 32, lane); acc[j] = mma32(vf, wf, acc[j]); } }
    { const int t = tb * 32 + r; const float bias = a.in[16][(l * 4 + g) * 128 + t];
      const bf16_t* prow = P + (size_t)(r0 + t) * NB + g * 256 + 4 * hh; bf16_t* arow = ACT + (size_t)(r0 + t) * D + 1024 + g * 256 + 4 * hh;
#pragma unroll
      for (int j = 0; j < 4; ++j)
#pragma unroll
        for (int q4 = 0; q4 < 4; ++q4) { const int chb = (cb0 + j) * 32 + 8 * q4;
            const u32x2 ur = *(const u32x2*)(prow + 5120 + chb), zr = *(const u32x2*)(prow + 7168 + chb);
            const float o0 = geluf_(bflo(ur.x)) * (acc[j][4 * q4 + 0] + bias) * siluf_(bflo(zr.x)), o1 = geluf_(bfhi(ur.x)) * (acc[j][4 * q4 + 1] + bias) * siluf_(bfhi(zr.x));
            const float o2 = geluf_(bflo(ur.y)) * (acc[j][4 * q4 + 2] + bias) * siluf_(bflo(zr.y)), o3 = geluf_(bfhi(ur.y)) * (acc[j][4 * q4 + 3] + bias) * siluf_(bfhi(zr.y));
            u32x2 o; o.x = cvt_pk_bf16(o0, o1); o.y = cvt_pk_bf16(o2, o3); *(u32x2*)(arow + chb) = o; } }
    __syncthreads();
}

__device__ __forceinline__ void sample_item(const Args& a, int l, int item, LAS unsigned char* lds, int tid, int lane, int wave) {
    const int rr = item >> 2, h = item & 3, R = MP + rr;
    LAS float* q = (LAS float*)lds; LAS float* k = q + 256; LAS float* vv = q + 512; LAS float* n0 = q + 768; LAS float* CQ = q + 1024; LAS float* HH = q + 1280; LAS float* RED = q + 1536;
    const bf16_t* P = (const bf16_t*)(a.ws + WS_P);
    bf16_t* ACT = (bf16_t*)(a.ws + WS_ACT);
    const bf16_t* prow = P + (size_t)R * NB;
    const size_t sidx = (size_t)(l * 128 + rr) * 4 + h;
    if (tid < 256) { q[tid] = bf2f(prow[h * 256 + tid]); k[tid] = bf2f(prow[1024 + h * 256 + tid]) * 0.0625f; vv[tid] = bf2f(prow[2048 + h * 256 + tid]); n0[tid] = a.in[3][sidx * 256 + tid]; }
    __syncthreads();
    const float ig = ((const float*)(a.ws + WS_IG))[R * 4 + h], lf = ((const float*)(a.ws + WS_LF))[R * 4 + h], m0 = a.in[4][sidx];
    const float a_ = lf + m0, mt = fmaxf(a_, ig), wintra = __expf(ig - mt), winter = __expf(a_ - mt);
    const f32x4 q4 = *(const LAS f32x4*)(q + lane * 4), k4 = *(const LAS f32x4*)(k + lane * 4), n4 = *(const LAS f32x4*)(n0 + lane * 4);
    const float qk = wave_sum((q4[0] * k4[0] + q4[1] * k4[1]) + (q4[2] * k4[2] + q4[3] * k4[3]));
    const float nq = wave_sum((q4[0] * n4[0] + q4[1] * n4[1]) + (q4[2] * n4[2] + q4[3] * n4[3]));
    const float s = qk * wintra, den = winter * nq + s, inv = 1.0f / fmaxf(fabsf(den), __expf(-mt));
    const float* C0 = a.in[2] + sidx * 65536; float* C1 = a.out + OCS + sidx * 65536;
#pragma unroll 8
    for (int i = 0; i < 32; ++i) { const int vrow = wave * 32 + i;
        const f32x4 c4 = __builtin_nontemporal_load((const f32x4*)(C0 + (size_t)vrow * 256 + lane * 4));
        float dot = (c4[0] * q4[0] + c4[1] * q4[1]) + (c4[2] * q4[2] + c4[3] * q4[3]);
        const float gv = wintra * vv[vrow];
        const f32x4 cn = c4 * winter + k4 * gv;
        __builtin_nontemporal_store(cn, (f32x4*)(C1 + (size_t)vrow * 256 + lane * 4));
        dot = wave_sum(dot); if (lane == 0) CQ[vrow] = dot; }
    __syncthreads();
    float hv = 0.f, xg = 0.f;
    if (tid < 256) { const float num = winter * CQ[tid] + s * vv[tid]; hv = num * inv * sigmoidf_(bf2f(prow[3072 + h * 256 + tid])); HH[tid] = hv;
        a.out[ONS + sidx * 256 + tid] = winter * n0[tid] + wintra * k[tid];
        const float p = wave_sum(hv * hv); if (lane == 0) RED[wave] = p; }
    else { xg = geluf_(bf2f(prow[6144 + h * 256 + (tid - 256)])); const float p = wave_sum(xg); if (lane == 0) RED[wave] = p; }
    if (tid == 0) a.out[OMS + sidx] = mt;
    __syncthreads();
    if (tid < 256) { const float rstd = rsqrtf(((RED[0] + RED[1]) + (RED[2] + RED[3])) * (1.0f / 256.0f) + EPS);
        ACT[(size_t)R * D + h * 256 + tid] = f2bf(hv * rstd * a.in[13][l * 1024 + h * 256 + tid] * siluf_(bf2f(prow[4096 + h * 256 + tid]))); }
    else { const float mean = ((RED[4] + RED[5]) + (RED[6] + RED[7])) * (1.0f / 256.0f); xg -= mean; const float p = wave_sum(xg * xg); if (lane == 0) RED[4 + wave] = p; }
    __syncthreads();
    if (tid >= 256) { const int ch = tid - 256; const float rstd = rsqrtf(((RED[8] + RED[9]) + (RED[10] + RED[11])) * (1.0f / 256.0f) + EPS);
        const float vn = xg * rstd * a.in[14][l * 1024 + h * 256 + ch];
        a.out[OVS + (size_t)(l * 128 + rr) * 1024 + h * 256 + ch] = vn;
        const float w00 = a.in[15][(size_t)(l * 4 + h) * 16384], b0 = a.in[16][(l * 4 + h) * 128];
        ACT[(size_t)R * D + 1024 + h * 256 + ch] = f2bf(geluf_(bf2f(prow[5120 + h * 256 + ch])) * (w00 * vn + b0) * siluf_(bf2f(prow[7168 + h * 256 + ch]))); }
    __syncthreads();
}

__device__ __forceinline__ void mlstm_out_item(const Args& a, int l, int item, LAS unsigned char* lds, int tid, int lane, int wave) {
    const int bh = item >> 4, c = item & 15, b = bh >> 2, h = bh & 3, r0 = b * 2048 + c * 128;
    LAS unsigned char* KC = lds;
    LAS unsigned char* SS = lds + 67584;
    LAS unsigned char* VV = lds + 67584 + 34816;
    LAS float* SM = (LAS float*)(lds + 137216);
    LAS float* E = SM; LAS float* MX = SM + 128; LAS float* BT = SM + 256; LAS float* NQ = SM + 384; LAS float* INV = SM + 512; LAS float* WI = SM + 640; LAS float* SSQ = SM + 768; LAS float* NV = SM + 1024;
    const bf16_t* P = (const bf16_t*)(a.ws + WS_P);
    bf16_t* ACT = (bf16_t*)(a.ws + WS_ACT);
    const bf16_t* CST = (const bf16_t*)(a.ws + WS_CST) + (size_t)(bh * 16 + c) * 65536;
    const int tb = wave >> 1, sub = wave & 1, r = lane & 31, hh = lane >> 5;
    const float m_c = ((const float*)(a.ws + WS_MST))[bh * 16 + c];
    if (wave == 0) { float b0, b1, e0, e1, cm0, cm1;
        chunk_scan((const float*)(a.ws + WS_IG), (const float*)(a.ws + WS_LF), r0, h, lane, b0, b1, e0, e1, cm0, cm1);
        E[2 * lane] = e0; E[2 * lane + 1] = e1; MX[2 * lane] = fmaxf(m_c, cm0); MX[2 * lane + 1] = fmaxf(m_c, cm1); BT[2 * lane] = b0; BT[2 * lane + 1] = b1; }
    if (tid < 256) NV[tid] = ((const float*)(a.ws + WS_NST))[(bh * 16 + c) * 256 + tid];
#pragma unroll
    for (int i2 = 0; i2 < 8; ++i2) { const int i = tid + i2 * 512, s = i >> 5, ch = i & 31;
        *(LAS u32x4*)(KC + s * 528 + ch * 16) = *(const u32x4*)(P + (size_t)(r0 + s) * NB + 1024 + h * 256 + ch * 8); }
    bf16x8 qf[16];
    { const bf16_t* qrow = P + (size_t)(r0 + tb * 32 + r) * NB + h * 256 + 8 * hh;
#pragma unroll
      for (int ks = 0; ks < 16; ++ks) qf[ks] = *(const bf16x8*)(qrow + ks * 16); }
    __syncthreads();
    if (sub == 0) { float p = 0.f;
#pragma unroll
        for (int ks = 0; ks < 16; ++ks)
#pragma unroll
            for (int j = 0; j < 8; ++j) p += bf2f((bf16_t)qf[ks][j]) * NV[16 * ks + 8 * hh + j];
        p += __shfl_xor(p, 32); if (hh == 0) NQ[tb * 32 + r] = p; }
    const int t = tb * 32 + r;
#pragma unroll
    for (int jb = 0; jb < 2; ++jb) { const int sb = 2 * sub + jb;
        if (sb <= tb) { f32x16 acc = zero16();
#pragma unroll
            for (int ks = 0; ks < 16; ++ks) { const bf16x8 kf = frag_row(KC, 528, sb * 32, ks * 16, lane); acc = mma32(kf, qf[ks], acc); }
            const float mxt = MX[t];
#pragma unroll
            for (int q4 = 0; q4 < 4; ++q4) { const int s0 = sb * 32 + 8 * q4 + 4 * hh; const f32x4 e4 = *(const LAS f32x4*)(E + s0);
                const float w0 = (s0 + 0 <= t) ? __expf(e4[0] - mxt) * 0.0625f : 0.f, w1 = (s0 + 1 <= t) ? __expf(e4[1] - mxt) * 0.0625f : 0.f;
                const float w2 = (s0 + 2 <= t) ? __expf(e4[2] - mxt) * 0.0625f : 0.f, w3 = (s0 + 3 <= t) ? __expf(e4[3] - mxt) * 0.0625f : 0.f;
                u32x2 o; o.x = cvt_pk_bf16(acc[4 * q4 + 0] * w0, acc[4 * q4 + 1] * w1); o.y = cvt_pk_bf16(acc[4 * q4 + 2] * w2, acc[4 * q4 + 3] * w3);
                *(LAS u32x2*)(SS + t * 272 + s0 * 2) = o; } } }
    __syncthreads();
    f32x16 hval[2][2];
#pragma unroll
    for (int hv = 0; hv < 2; ++hv) {
        if (hv) __syncthreads();
#pragma unroll
        for (int i2 = 0; i2 < 4; ++i2) { const int i = tid + i2 * 512, s = i >> 4, ch = i & 15;
            *(LAS u32x4*)(VV + s * 272 + ch * 16) = *(const u32x4*)(P + (size_t)(r0 + s) * NB + 2048 + h * 256 + hv * 128 + ch * 8); }
#pragma unroll
        for (int i2 = 0; i2 < 8; ++i2) { const int i = tid + i2 * 512, v = i >> 5, ch = i & 31;
            *(LAS u32x4*)(KC + v * 528 + ch * 16) = *(const u32x4*)(CST + (size_t)(hv * 128 + v) * 256 + ch * 8); }
        if (hv == 0) { const int tt = tid >> 2, part = tid & 3; float sum = 0.f;
            if (part <= (tt >> 5)) {
#pragma unroll
                for (int j = 0; j < 4; ++j) { const u32x4 w = *(const LAS u32x4*)(SS + tt * 272 + part * 64 + j * 16);
                    sum += (bflo(w.x) + bfhi(w.x)) + (bflo(w.y) + bfhi(w.y)) + (bflo(w.z) + bfhi(w.z)) + (bflo(w.w) + bfhi(w.w)); } }
            sum += __shfl_xor(sum, 1); sum += __shfl_xor(sum, 2);
            if (part == 0) { const float wi = __expf(m_c - MX[tt]); const float den = wi * NQ[tt] + sum; const float mt = BT[tt] + MX[tt];
                INV[tt] = 1.0f / fmaxf(fabsf(den), __expf(-mt)); WI[tt] = wi; } }
        __syncthreads();
        const float wi = WI[t], inv = INV[t];
#pragma unroll
        for (int jb = 0; jb < 2; ++jb) { const int vb = 2 * sub + jb; f32x16 acc = zero16();
#pragma unroll
            for (int ks = 0; ks < 16; ++ks) { const bf16x8 cf = frag_row(KC, 528, vb * 32, ks * 16, lane); acc = mma32(cf, qf[ks], acc); }
#pragma unroll
            for (int reg = 0; reg < 16; ++reg) acc[reg] *= wi;
            for (int ks = 0; ks < 2 * (tb + 1); ++ks) { const bf16x8 sf = frag_row(SS, 272, tb * 32, ks * 16, lane); const bf16x8 vf = frag_tr(VV, 272, ks * 16, vb * 32, lane); acc = mma32(vf, sf, acc); }
            const bf16_t* orow = P + (size_t)(r0 + t) * NB + 3072 + h * 256 + hv * 128 + vb * 32 + 4 * hh;
#pragma unroll
            for (int q4 = 0; q4 < 4; ++q4) { const u32x2 raw = *(const u32x2*)(orow + 8 * q4);
                acc[4 * q4 + 0] *= inv * sigmoidf_(bflo(raw.x)); acc[4 * q4 + 1] *= inv * sigmoidf_(bfhi(raw.x));
                acc[4 * q4 + 2] *= inv * sigmoidf_(bflo(raw.y)); acc[4 * q4 + 3] *= inv * sigmoidf_(bfhi(raw.y)); }
            hval[hv][jb] = acc; }
    }
    { float s2 = 0.f;
#pragma unroll
      for (int reg = 0; reg < 16; ++reg) s2 += (hval[0][0][reg] * hval[0][0][reg] + hval[0][1][reg] * hval[0][1][reg]) + (hval[1][0][reg] * hval[1][0][reg] + hval[1][1][reg] * hval[1][1][reg]);
      s2 += __shfl_xor(s2, 32);
      if (hh == 0) SSQ[sub * 128 + t] = s2; }
    __syncthreads();
    { const float rstd = rsqrtf((SSQ[t] + SSQ[128 + t]) * (1.0f / 256.0f) + EPS);
      const float* gm = a.in[13] + l * 1024 + h * 256 + 4 * hh;
      const bf16_t* zrow = P + (size_t)(r0 + t) * NB + 4096 + h * 256 + 4 * hh; bf16_t* arow = ACT + (size_t)(r0 + t) * D + h * 256 + 4 * hh;
#pragma unroll
      for (int hv = 0; hv < 2; ++hv)
#pragma unroll
        for (int jb = 0; jb < 2; ++jb)
#pragma unroll
            for (int q4 = 0; q4 < 4; ++q4) { const int cb = hv * 128 + (2 * sub + jb) * 32 + 8 * q4;
                const u32x2 zr = *(const u32x2*)(zrow + cb); const f32x4 g4 = *(const f32x4*)(gm + cb);
                u32x2 o; o.x = cvt_pk_bf16(hval[hv][jb][4 * q4 + 0] * rstd * g4[0] * siluf_(bflo(zr.x)), hval[hv][jb][4 * q4 + 1] * rstd * g4[1] * siluf_(bfhi(zr.x)));
                o.y = cvt_pk_bf16(hval[hv][jb][4 * q4 + 2] * rstd * g4[2] * siluf_(bflo(zr.y)), hval[hv][jb][4 * q4 + 3] * rstd * g4[3] * siluf_(bfhi(zr.y)));
                *(u32x2*)(arow + cb) = o; } }
    __syncthreads();
}

__device__ __forceinline__ void phase_final(const Args& a, int tid, int lane, int wave, int G, int bid) {
    const float* gf = a.in[18];
    for (int r = bid * 8 + wave; r < MT; r += G * 8) {
        float* xr = a.out + OY + (size_t)r * D + lane * 4;
        f32x4 v[8]; float ss = 0.f;
#pragma unroll
        for (int i = 0; i < 8; ++i) { v[i] = *(const f32x4*)(xr + 256 * i); ss += (v[i][0] * v[i][0] + v[i][1] * v[i][1]) + (v[i][2] * v[i][2] + v[i][3] * v[i][3]); }
        const float rstd = rsqrtf(wave_sum(ss) * (1.0f / D) + EPS);
#pragma unroll
        for (int i = 0; i < 8; ++i) { const f32x4 g = *(const f32x4*)(gf + lane * 4 + 256 * i); *(f32x4*)(xr + 256 * i) = v[i] * rstd * g; }
    }
}

__global__ void __launch_bounds__(512, 2) fwd_megakernel(Args a) {
    extern __shared__ __attribute__((aligned(16))) unsigned char lds_raw[];
    LAS unsigned char* lds = (LAS unsigned char*)lds_raw;
    cg::grid_group grid = cg::this_grid();
    const int G = gridDim.x, bid = blockIdx.x;
    const int lo = a.ph_lo, hi = a.ph_hi;
#define IN(k) (lo <= (k) && (k) < hi)
#define SEAM(k) do { if (IN(k) && IN((k) + 1)) grid.sync(); } while (0)
#define TIDS int tid = threadIdx.x; asm volatile("" : "+v"(tid)); const int lane = tid & 63, wave = __builtin_amdgcn_readfirstlane(tid >> 6);
    if (IN(0)) { TIDS phase0(a, lds, tid, lane, wave, G, bid); }
    SEAM(0);
    if (IN(1)) { TIDS phase_ada(a, lds, tid, lane, wave, G, bid); }
    SEAM(1);
#pragma unroll 1
    for (int l = 0; l < 2; ++l) {
        const int pb = 2 + 5 * l;
        if (IN(pb)) { TIDS phase_norm(a, l, lds, tid, lane, wave, G, bid); }
        SEAM(pb);
        if (IN(pb + 1)) {
            pg8::Gemm g{(const bf16_t*)(a.ws + WS_HN), (const bf16_t*)(a.ws + WS_WIN) + (size_t)l * NB * D, MPAD, NB, D};
            pg8::StaticOrder S; S.init(MPAD, NB, G, bid);
            pg8::EpiP E{(bf16_t*)(a.ws + WS_P), NB};
            pg8::gemm_phase<pg8::EpiP, pg8::StaticOrder>(lds, g, S, E);
        }
        SEAM(pb + 1);
        if (IN(pb + 2)) {
#pragma unroll 1
            for (int item = bid; item < 896; item += G) { TIDS
                if (item < 128) scan_item(a, l, item, lds, tid, lane, wave);
                else if (item < 384) mix_item(a, l, item - 128, lds, tid, lane, wave);
                else sample_item(a, l, item - 384, lds, tid, lane, wave);
            }
        }
        SEAM(pb + 2);
        if (IN(pb + 3)) {
#pragma unroll 1
            for (int item = bid; item < 256; item += G) { TIDS mlstm_out_item(a, l, item, lds, tid, lane, wave); }
        }
        SEAM(pb + 3);
        if (IN(pb + 4)) {
            pg8::Gemm g{(const bf16_t*)(a.ws + WS_ACT), (const bf16_t*)(a.ws + WS_WOUT) + (size_t)l * D * D, MPAD, D, D};
            pg8::StaticOrder S; S.init(MPAD, D, G, bid);
            pg8::EpiRes E{l == 0 ? a.in[0] : (const float*)(a.ws + WS_X1), l == 0 ? a.in[1] : (const float*)(a.ws + WS_X1) + (size_t)MP * D,
                          l == 0 ? (float*)(a.ws + WS_X1) : a.out + OY, (const float*)(a.ws + WS_MOD) + (size_t)l * NCR * NMOD};
            pg8::gemm_phase<pg8::EpiRes, pg8::StaticOrder>(lds, g, S, E);
        }
        SEAM(pb + 4);
    }
    if (IN(12)) { TIDS phase_final(a, tid, lane, wave, G, bid); }
#undef TIDS
#undef IN
#undef SEAM
}

#ifndef N_LAUNCH_MODE
#define N_LAUNCH_MODE 1
#endif

extern "C" void kernel_launch(void* const* d_in, const int* in_sizes, int n_in, void* d_out, int out_size, void* d_ws, size_t ws_size, hipStream_t stream) {
    static int grid = 0;
    if (grid == 0) {
        int dev = 0, cus = 0, per_cu = 0;
        hipGetDevice(&dev);
        hipDeviceGetAttribute(&cus, hipDeviceAttributeMultiprocessorCount, dev);
        hipFuncSetAttribute((const void*)fwd_megakernel, hipFuncAttributeMaxDynamicSharedMemorySize, LDS_BYTES);
        hipOccupancyMaxActiveBlocksPerMultiprocessor(&per_cu, (const void*)fwd_megakernel, 512, LDS_BYTES);
        if (per_cu < 1) { fprintf(stderr, "occupancy query returned %d\n", per_cu); per_cu = 1; }
        grid = cus * per_cu;
        if (n_in != 19 || ws_size < WS_END) { fprintf(stderr, "unexpected n_in %d / ws %zu\n", n_in, ws_size); }
    }
    Args a{};
    for (int i = 0; i < 19; ++i) a.in[i] = (const float*)d_in[i];
    a.out = (float*)d_out; a.ws = (unsigned char*)d_ws;
#if N_LAUNCH_MODE == 1
    a.ph_lo = 0; a.ph_hi = NPHASE;
    void* args[] = {&a};
    hipError_t e = hipLaunchCooperativeKernel((const void*)fwd_megakernel, dim3(grid), dim3(512), args, LDS_BYTES, stream);
    if (e != hipSuccess) fprintf(stderr, "cooperative launch failed: %s (grid %d)\n", hipGetErrorString(e), grid);
#else
    for (int p = 0; p < NPHASE; ++p) {
        a.ph_lo = p; a.ph_hi = p + 1;
        void* args[] = {&a};
        hipError_t e = hipLaunchCooperativeKernel((const void*)fwd_megakernel, dim3(grid), dim3(512), args, LDS_BYTES, stream);
        if (e != hipSuccess) { fprintf(stderr, "launch %d failed: %s (grid %d)\n", p, hipGetErrorString(e), grid); break; }
    }
#endif
}
```

```cpp
#include <hip/hip_runtime.h>
#include <hip/hip_cooperative_groups.h>
#include <cstdio>
namespace cg = cooperative_groups;

#define LAS __attribute__((address_space(3)))
typedef unsigned short bf16_t;
typedef short bf16x8 __attribute__((ext_vector_type(8)));
typedef short s16x4 __attribute__((ext_vector_type(4)));
typedef float f32x4 __attribute__((ext_vector_type(4)));
typedef float f32x16 __attribute__((ext_vector_type(16)));
typedef unsigned u32x4 __attribute__((ext_vector_type(4)));
typedef unsigned u32x2 __attribute__((ext_vector_type(2)));

constexpr int D = 2048, MP = 8192, MS = 128, MT = 8320, MPAD = 8448;
constexpr int NB = 8192, DIN = 8200, NMOD = 6144, NCR = 132;
constexpr float EPS = 1e-6f;
constexpr size_t OY = 0, OCP = 17039360, ONP = 19136512, OMP = 19144704, OCS = 19144736, ONS = 86253600, OMS = 86515744, OVS = 86516768;
constexpr size_t MiB = 1u << 20;
constexpr size_t WS_WIN = 1 * MiB;
constexpr size_t WS_WOUT = 65 * MiB;
constexpr size_t WS_SC = 81 * MiB;
constexpr size_t WS_MOD = 82 * MiB;
constexpr size_t WS_HN = 90 * MiB;
constexpr size_t WS_P = 123 * MiB;
constexpr size_t WS_IG = 255 * MiB;
constexpr size_t WS_LF = 255 * MiB + 512 * 1024;
constexpr size_t WS_X1 = 256 * MiB;
constexpr size_t WS_ACT = 321 * MiB;
constexpr size_t WS_CST = 354 * MiB;
constexpr size_t WS_NST = 386 * MiB;
constexpr size_t WS_MST = 386 * MiB + 512 * 1024;
constexpr size_t WS_END = 387 * MiB;
constexpr int LDS_BYTES = 155648;
constexpr int NPHASE = 13;
#ifndef PROBE
#define PROBE 0
#endif

struct Args { const float* in[19]; float* out; unsigned char* ws; int ph_lo, ph_hi; };

__device__ __forceinline__ float bf2f(bf16_t b) { return __uint_as_float(((unsigned)b) << 16); }
__device__ __forceinline__ float bflo(unsigned w) { return __uint_as_float(w << 16); }
__device__ __forceinline__ float bfhi(unsigned w) { return __uint_as_float(w & 0xffff0000u); }
__device__ __forceinline__ unsigned cvt_pk_bf16(float lo, float hi) { unsigned r; asm volatile("v_cvt_pk_bf16_f32 %0, %1, %2" : "=v"(r) : "v"(lo), "v"(hi)); return r; }
__device__ __forceinline__ bf16_t f2bf(float f) { return (bf16_t)(cvt_pk_bf16(f, 0.f) & 0xffffu); }
__device__ __forceinline__ float sigmoidf_(float x) { return 1.0f / (1.0f + __expf(-x)); }
__device__ __forceinline__ float siluf_(float x) { return x / (1.0f + __expf(-x)); }
__device__ __forceinline__ float geluf_(float x) { const float u = 1.5957691216f * (x + 0.044715f * x * x * x); return x / (1.0f + __expf(-u)); }
__device__ __forceinline__ float wave_sum(float v) {
#pragma unroll
    for (int o = 1; o < 64; o <<= 1) v += __shfl_xor(v, o);
    return v;
}
__device__ __forceinline__ int rowof(int reg, int hh) { return (reg & 3) + 8 * (reg >> 2) + 4 * hh; }
__device__ __forceinline__ bf16x8 frag_row(const LAS unsigned char* base, int ldb, int row0, int k0, int lane) {
    return *(const LAS bf16x8*)(base + (row0 + (lane & 31)) * ldb + (k0 + 8 * (lane >> 5)) * 2);
}
__device__ __forceinline__ bf16x8 frag_tr(const LAS unsigned char* base, int ldb, int k0, int n0, int lane) {
    const int hh = lane >> 5, blk = (lane >> 4) & 1, q = (lane & 15) >> 2, p = lane & 3;
    const LAS unsigned char* a = base + (k0 + 8 * hh + q) * ldb + (n0 + 16 * blk + 4 * p) * 2;
    const s16x4 lo = __builtin_amdgcn_ds_read_tr16_b64_v4i16((LAS s16x4*)a);
    const s16x4 hi = __builtin_amdgcn_ds_read_tr16_b64_v4i16((LAS s16x4*)(a + 4 * ldb));
    return (bf16x8){lo[0], lo[1], lo[2], lo[3], hi[0], hi[1], hi[2], hi[3]};
}
__device__ __forceinline__ f32x16 mma32(bf16x8 a, bf16x8 b, f32x16 c) { return __builtin_amdgcn_mfma_f32_32x32x16_bf16(a, b, c, 0, 0, 0); }
__device__ __forceinline__ f32x16 zero16() { f32x16 z;
#pragma unroll
    for (int i = 0; i < 16; ++i) z[i] = 0.f;
    return z; }

namespace pg8 {
constexpr int BM = 256, BK = 64, HALF = 128, HTB = HALF * BK * 2, STAGE_BYTES = 8 * HTB, NXCD = 8, WGM = 8;
__device__ __forceinline__ int lds_byte(int r, int c) { const int st = (r >> 4) * 2 + (c >> 5), rr = r & 15, cc = c & 31, ob = rr * 64 + cc * 2; return st * 1024 + (ob ^ (((ob >> 9) & 1) << 5)); }
__device__ __forceinline__ void stage_rc(int b, int& R, int& C) { const int st = b / 1024, sb = b % 1024, swz = sb ^ (((sb >> 9) & 1) << 5); R = (st >> 1) * 16 + swz / 64; C = (st & 1) * 32 + (swz % 64) / 2; }
__device__ __forceinline__ int perm32(int rho) { const int n = rho >> 4, i = rho & 15; return 8 * (i >> 2) + 4 * n + (i & 3); }
struct Unit { int pm, pn; };
struct Gemm { const bf16_t* A; const bf16_t* Bt; int M, N, K; };
struct StaticOrder {
    int nM, nN, nwg, G, c;
    __device__ void init(int M, int N, int G_, int c_) { nM = M / BM; nN = N / BM; nwg = nM * nN; G = G_; c = c_; }
    __device__ bool next(int i, Unit& u) const {
        const long L = (long)i * G + c; if (L >= nwg) return false;
        int wgid = (int)L; { const int q = nwg / NXCD, r = nwg % NXCD, xcd = wgid % NXCD, off = wgid / NXCD; wgid = (xcd < r ? xcd * (q + 1) : r * (q + 1) + (xcd - r) * q) + off; }
        const int nig = WGM * nN, gid = wgid / nig, fm = gid * WGM, gsz = (nM - fm) < WGM ? (nM - fm) : WGM;
        u.pm = fm + ((wgid % nig) % gsz); u.pn = (wgid % nig) / gsz; return true;
    }
};
struct EpiP {
    static constexpr bool PERM = true;
    bf16_t* O; int ldc;
    __device__ __forceinline__ void operator()(const f32x4 (&acc)[2][2][4][2], const Unit& u, int wr, int wc, int fr, int fq) const {
        const int row0 = u.pm * BM + wr * 64 + fr, col0 = u.pn * BM + wc * 32 + 8 * fq;
#pragma unroll
        for (int ai = 0; ai < 2; ++ai)
#pragma unroll
            for (int m = 0; m < 4; ++m) { bf16_t* rowp = O + (size_t)(row0 + ai * HALF + m * 16) * ldc + col0;
#pragma unroll
                for (int bj = 0; bj < 2; ++bj) { const f32x4 v0 = acc[ai][bj][m][0], v1 = acc[ai][bj][m][1];
                    u32x4 w; w.x = cvt_pk_bf16(v0[0], v0[1]); w.y = cvt_pk_bf16(v0[2], v0[3]); w.z = cvt_pk_bf16(v1[0], v1[1]); w.w = cvt_pk_bf16(v1[2], v1[3]);
                    *(u32x4*)(rowp + bj * HALF) = w; } }
    }
};
struct EpiRes {
    static constexpr bool PERM = false;
    const float* xp; const float* xs; float* dst; const float* mod;
    __device__ __forceinline__ void operator()(const f32x4 (&acc)[2][2][4][2], const Unit& u, int wr, int wc, int fr, int fq) const {
        const int row0 = u.pm * BM + wr * 64 + fr, col0 = u.pn * BM + wc * 32 + 4 * fq;
#pragma unroll
        for (int ai = 0; ai < 2; ++ai)
#pragma unroll
            for (int m = 0; m < 4; ++m) { const int r = row0 + ai * HALF + m * 16;
                if (r < MT) {
                    const int mrow = r < MP ? (r >> 11) : 4 + (r - MP);
                    const float* xo = (r < MP ? xp + (size_t)r * D : xs + (size_t)(r - MP) * D) + col0;
                    const float* gp = mod + (size_t)mrow * NMOD + 4096 + col0;
                    float* dp = dst + (size_t)r * D + col0;
#pragma unroll
                    for (int bj = 0; bj < 2; ++bj)
#pragma unroll
                        for (int n = 0; n < 2; ++n) { const f32x4 g = *(const f32x4*)(gp + bj * HALF + n * 16); const f32x4 x = *(const f32x4*)(xo + bj * HALF + n * 16);
                            *(f32x4*)(dp + bj * HALF + n * 16) = x + g * acc[ai][bj][m][n]; } } }
    }
};

template <class Epi, class Sched>
__device__ __forceinline__ void gemm_phase(LAS unsigned char* lds, const Gemm g, const Sched& S, const Epi& E) {
    int tid = threadIdx.x; asm volatile("" : "+v"(tid));
    const int wid = __builtin_amdgcn_readfirstlane(tid >> 6), lane = tid & 63, wr = wid >> 2, wc = wid & 3, fr = lane & 15, fq = lane >> 4;
    const int K = g.K, nt = K / BK;
    unsigned voffA[2], voffB[2];
#pragma unroll
    for (int i = 0; i < 2; ++i) { int R, C; stage_rc(tid * 16 + i * 8192, R, C); const int Rb = Epi::PERM ? ((R & ~31) + perm32(R & 31)) : R;
        voffA[i] = (unsigned)(R * K + C) * 2u; voffB[i] = (unsigned)(Rb * K + C) * 2u; }
    const size_t kstep = (size_t)(BK * 2);
    const size_t hstep = (size_t)HALF * K * 2;
    const size_t tstep = 2 * hstep;
    const unsigned ldsw = (unsigned)wid * 1024u;
    const int aoff = lds_byte(wr * 64 + fr, fq * 8), boff = lds_byte(wc * 32 + fr, fq * 8);
#define PG8_SA(b, h) (((b) * 2 + (h)) * HTB)
#define PG8_SB(b, h) ((4 + (b) * 2 + (h)) * HTB)
#define PG8_STAGE(bufoff, gbase, voff) do { _Pragma("unroll") for (int _i = 0; _i < 2; ++_i) \
        __builtin_amdgcn_global_load_lds((const unsigned*)((const char*)(gbase) + (voff)[_i]), (LAS unsigned*)(lds + (bufoff) + ldsw + _i * 8192), 16, 0, 0); } while (0)
#define PG8_LDA(dst, b, h) do { _Pragma("unroll") for (int m = 0; m < 4; ++m) _Pragma("unroll") for (int k = 0; k < 2; ++k) dst[m][k] = *(const LAS bf16x8*)(lds + PG8_SA(b, h) + aoff + m * 2048 + k * 1024); } while (0)
#define PG8_LDB(dst, b, h) do { _Pragma("unroll") for (int n = 0; n < 2; ++n) _Pragma("unroll") for (int k = 0; k < 2; ++k) dst[n][k] = *(const LAS bf16x8*)(lds + PG8_SB(b, h) + boff + n * 2048 + k * 1024); } while (0)
#define PG8_MMA(ai, bj, At, Bt) do { __builtin_amdgcn_s_setprio(1); _Pragma("unroll") for (int m = 0; m < 4; ++m) _Pragma("unroll") for (int n = 0; n < 2; ++n) _Pragma("unroll") for (int k = 0; k < 2; ++k) \
        acc[ai][bj][m][n] = __builtin_amdgcn_mfma_f32_16x16x32_bf16(Bt[n][k], At[m][k], acc[ai][bj][m][n], 0, 0, 0); __builtin_amdgcn_s_setprio(0); } while (0)
#define PG8_WAIT_V(n) asm volatile("s_waitcnt vmcnt(" #n ")" ::: "memory")
#define PG8_WAIT_L(n) asm volatile("s_waitcnt lgkmcnt(" #n ")" ::: "memory")
#define PG8_BAR __builtin_amdgcn_s_barrier()
#define PG8_SCHED __builtin_amdgcn_sched_barrier(0)
    Unit cur, nxt; int ui = 0;
    if (!S.next(0, cur)) return;
    f32x4 acc[2][2][4][2];
#pragma unroll
    for (int a = 0; a < 2; ++a)
#pragma unroll
        for (int b = 0; b < 2; ++b)
#pragma unroll
            for (int m = 0; m < 4; ++m)
#pragma unroll
                for (int n = 0; n < 2; ++n) acc[a][b][m][n] = (f32x4){0.f, 0.f, 0.f, 0.f};
    bf16x8 At[4][2], B0[2][2], B1[2][2];
    const char* cA = (const char*)g.A + (size_t)cur.pm * tstep; const char* cB = (const char*)g.Bt + (size_t)cur.pn * tstep;
    PG8_STAGE(PG8_SB(0, 0), cB, voffB); PG8_STAGE(PG8_SA(0, 0), cA, voffA); PG8_STAGE(PG8_SB(0, 1), cB + hstep, voffB); PG8_STAGE(PG8_SA(0, 1), cA + hstep, voffA);
    if (wr == 1) PG8_BAR;
    PG8_WAIT_V(4); PG8_BAR;
    PG8_STAGE(PG8_SB(1, 0), cB + kstep, voffB); PG8_STAGE(PG8_SA(1, 0), cA + kstep, voffA); PG8_STAGE(PG8_SB(1, 1), cB + hstep + kstep, voffB);
    PG8_WAIT_V(6); PG8_BAR;
    for (;;) {
        const bool has_next = S.next(ui + 1, nxt);
        const char* nA = has_next ? (const char*)g.A + (size_t)nxt.pm * tstep : cA; const char* nB = has_next ? (const char*)g.Bt + (size_t)nxt.pn * tstep : cB;
        for (int t = 0; t < nt; t += 2) {
            const bool last = (t == nt - 2);
            const char* a1 = cA + (size_t)(t + 1) * kstep;
            const char* a2 = last ? nA : cA + (size_t)(t + 2) * kstep; const char* b2 = last ? nB : cB + (size_t)(t + 2) * kstep;
            const char* a3 = a2 + kstep; const char* b3 = b2 + kstep;
            PG8_LDB(B0, 0, 0); PG8_SCHED; PG8_LDA(At, 0, 0); PG8_STAGE(PG8_SA(1, 1), a1 + hstep, voffA);
            PG8_WAIT_L(8); PG8_BAR; PG8_WAIT_L(0); PG8_MMA(0, 0, At, B0); PG8_BAR; PG8_SCHED;
            PG8_LDB(B1, 0, 1); PG8_STAGE(PG8_SB(0, 0), b2, voffB);
            PG8_BAR; PG8_WAIT_L(0); PG8_MMA(0, 1, At, B1); PG8_BAR;
            PG8_LDA(At, 0, 1); PG8_STAGE(PG8_SA(0, 0), a2, voffA);
            PG8_BAR; PG8_WAIT_L(0); PG8_MMA(1, 0, At, B0); PG8_BAR; PG8_SCHED;
            PG8_STAGE(PG8_SB(0, 1), b2 + hstep, voffB);
            PG8_WAIT_V(6); PG8_BAR; PG8_MMA(1, 1, At, B1); PG8_BAR;
            PG8_LDB(B0, 1, 0); PG8_SCHED; PG8_LDA(At, 1, 0); PG8_STAGE(PG8_SA(0, 1), a2 + hstep, voffA);
            PG8_WAIT_L(8); PG8_BAR; PG8_WAIT_L(0); PG8_MMA(0, 0, At, B0); PG8_BAR; PG8_SCHED;
            PG8_LDB(B1, 1, 1); PG8_STAGE(PG8_SB(1, 0), b3, voffB);
            PG8_BAR; PG8_WAIT_L(0); PG8_MMA(0, 1, At, B1); PG8_BAR;
            PG8_LDA(At, 1, 1); PG8_STAGE(PG8_SA(1, 0), a3, voffA);
            PG8_BAR; PG8_WAIT_L(0); PG8_MMA(1, 0, At, B0); PG8_BAR; PG8_SCHED;
            PG8_STAGE(PG8_SB(1, 1), b3 + hstep, voffB);
            PG8_WAIT_V(6); PG8_BAR; PG8_MMA(1, 1, At, B1); PG8_BAR;
        }
        E(acc, cur, wr, wc, fr, fq);
        if (!has_next) break;
#pragma unroll
        for (int a = 0; a < 2; ++a)
#pragma unroll
            for (int b = 0; b < 2; ++b)
#pragma unroll
                for (int m = 0; m < 4; ++m)
#pragma unroll
                    for (int n = 0; n < 2; ++n) acc[a][b][m][n] = (f32x4){0.f, 0.f, 0.f, 0.f};
        cur = nxt; cA = nA; cB = nB; ++ui;
    }
    PG8_WAIT_V(0);
    if (wr == 0) PG8_BAR;
    PG8_BAR;
#undef PG8_SA
#undef PG8_SB
#undef PG8_STAGE
#undef PG8_LDA
#undef PG8_LDB
#undef PG8_MMA
#undef PG8_WAIT_V
#undef PG8_WAIT_L
#undef PG8_BAR
#undef PG8_SCHED
}
}

template <int MODE>
__device__ __forceinline__ void skinny_item(const Args& a, int l, int n0, const bf16_t* Arows, const bf16_t* Bt, LAS unsigned char* lds, int tid, int lane, int wave) {
    LAS float* red = (LAS float*)lds;
    const int r = lane & 31, hh = lane >> 5;
    f32x16 acc[4];
#pragma unroll
    for (int i = 0; i < 4; ++i) acc[i] = zero16();
    const bf16_t* bp = Bt + (size_t)(n0 + r) * D + wave * 256 + 8 * hh;
    const bf16_t* ap = Arows + (size_t)r * D + wave * 256 + 8 * hh;
#pragma unroll 4
    for (int ks = 0; ks < 16; ++ks) { const bf16x8 bf = *(const bf16x8*)(bp + ks * 16);
#pragma unroll
        for (int rb = 0; rb < 4; ++rb) { const bf16x8 af = *(const bf16x8*)(ap + (size_t)rb * 32 * D + ks * 16); acc[rb] = mma32(bf, af, acc[rb]); } }
#pragma unroll
    for (int rb = 0; rb < 4; ++rb)
#pragma unroll
        for (int reg = 0; reg < 16; ++reg) red[((wave * 4 + rb) * 16 + reg) * 64 + lane] = acc[rb][reg];
    __syncthreads();
#pragma unroll
    for (int i = 0; i < 8; ++i) { const int e = tid + 512 * i; float sum = 0.f;
#pragma unroll
        for (int w = 0; w < 8; ++w) sum += red[w * 4096 + e];
        const int rb = e >> 10, reg = (e >> 6) & 15, ln = e & 63; const int m = rb * 32 + (ln & 31), n = n0 + rowof(reg, ln >> 5);
        if (MODE == 0) ((bf16_t*)(a.ws + WS_P))[(size_t)(MP + m) * NB + n] = f2bf(sum);
        else { const float* xs = l == 0 ? a.in[1] : (const float*)(a.ws + WS_X1) + (size_t)MP * D; float* dst = (l == 0 ? (float*)(a.ws + WS_X1) : a.out + OY) + (size_t)MP * D;
            const float gate = ((const float*)(a.ws + WS_MOD))[((size_t)l * NCR + 4 + m) * NMOD + 4096 + n];
            dst[(size_t)m * D + n] = xs[(size_t)m * D + n] + gate * sum; } }
    __syncthreads();
}

__device__ __forceinline__ void transpose_item(const float* W, int ldw, int nblk, bf16_t* WT, int K, int item, bool remap, LAS float* scr, int lane) {
    const int kb = item / nblk, nb = item % nblk, k0 = 64 * kb, n0 = 32 * nb;
    const int n0s = (remap && n0 >= 5120) ? n0 + 8 : n0;
#pragma unroll 8
    for (int i = 0; i < 32; ++i) { const int kk = 2 * i + (lane >> 5); scr[kk * 33 + (lane & 31)] = W[(size_t)(k0 + kk) * ldw + n0s + (lane & 31)]; }
    asm volatile("s_waitcnt lgkmcnt(0)" ::: "memory");
    const int c = lane & 7;
#pragma unroll
    for (int j = 0; j < 4; ++j) { const int n = (lane >> 3) + 8 * j; const LAS float* s = scr + (8 * c) * 33 + n;
        u32x4 o; o.x = cvt_pk_bf16(s[0 * 33], s[1 * 33]); o.y = cvt_pk_bf16(s[2 * 33], s[3 * 33]); o.z = cvt_pk_bf16(s[4 * 33], s[5 * 33]); o.w = cvt_pk_bf16(s[6 * 33], s[7 * 33]);
        *(u32x4*)(WT + (size_t)(n0 + n) * K + k0 + 8 * c) = o; }
    asm volatile("s_waitcnt lgkmcnt(0)" ::: "memory");
}
__device__ __forceinline__ void phase0(const Args& a, LAS unsigned char* lds, int tid, int lane, int wave, int G, int bid) {
    bf16_t* SC = (bf16_t*)(a.ws + WS_SC);
    const float* cp = a.in[5]; const float* cs = a.in[6];
    for (int i = bid * 512 + tid; i < 160 * 512; i += G * 512) {
        const int r = i >> 9, c4 = (i & 511) * 4;
        f32x4 v = (f32x4){0.f, 0.f, 0.f, 0.f};
        if (r < 4) v = *(const f32x4*)(cp + (size_t)r * D + c4); else if (r < NCR) v = *(const f32x4*)(cs + (size_t)(r - 4) * D + c4);
        u32x2 o; o.x = cvt_pk_bf16(siluf_(v[0]), siluf_(v[1])); o.y = cvt_pk_bf16(siluf_(v[2]), siluf_(v[3]));
        *(u32x2*)(SC + (size_t)r * D + c4) = o;
    }
    LAS float* scr = (LAS float*)(lds + wave * 8448);
    const int gw = bid * 8 + wave, NGW = G * 8;
    constexpr int I_IN = 32 * 256, I_OUT = 32 * 64;
    for (int it = gw; it < 2 * I_IN + 2 * I_OUT; it += NGW) {
        if (it < 2 * I_IN) { const int l = it / I_IN, r = it % I_IN;
            transpose_item(a.in[10] + (size_t)l * D * DIN, DIN, 256, (bf16_t*)(a.ws + WS_WIN) + (size_t)l * NB * D, D, r, true, scr, lane); }
        else { const int j = it - 2 * I_IN, l = j / I_OUT, r = j % I_OUT;
            transpose_item(a.in[17] + (size_t)l * D * D, D, 64, (bf16_t*)(a.ws + WS_WOUT) + (size_t)l * D * D, D, r, false, scr, lane); }
    }
}

__device__ __forceinline__ void phase_ada(const Args& a, LAS unsigned char* lds, int tid, int lane, int wave, int G, int bid) {
    const bf16_t* SC = (const bf16_t*)(a.ws + WS_SC);
    float* MOD = (float*)(a.ws + WS_MOD);
    LAS float* red = (LAS float*)lds;
    const int r = lane & 31, hh = lane >> 5;
    for (int item = bid; item < 384; item += G) {
        const int l = item / 192, n0 = (item % 192) * 32;
        const float* W = a.in[8] + (size_t)l * D * NMOD;
        const int kbase = wave * 256;
        f32x16 acc[5];
#pragma unroll
        for (int i = 0; i < 5; ++i) acc[i] = zero16();
#pragma unroll 2
        for (int ks = 0; ks < 16; ++ks) {
            const int k0 = kbase + ks * 16;
            const float* wp = W + (size_t)(k0 + 8 * hh) * NMOD + n0 + r;
            float wv[8];
#pragma unroll
            for (int j = 0; j < 8; ++j) wv[j] = wp[(size_t)j * NMOD];
            union { u32x4 u; bf16x8 v; } bfr;
            bfr.u.x = cvt_pk_bf16(wv[0], wv[1]); bfr.u.y = cvt_pk_bf16(wv[2], wv[3]); bfr.u.z = cvt_pk_bf16(wv[4], wv[5]); bfr.u.w = cvt_pk_bf16(wv[6], wv[7]);
#pragma unroll
            for (int rb = 0; rb < 5; ++rb) { const bf16x8 af = *(const bf16x8*)(SC + (size_t)(rb * 32 + r) * D + k0 + 8 * hh); acc[rb] = mma32(af, bfr.v, acc[rb]); }
        }
#pragma unroll
        for (int rb = 0; rb < 5; ++rb) {
#pragma unroll
            for (int reg = 0; reg < 16; ++reg) red[wave * 1024 + reg * 64 + lane] = acc[rb][reg];
            __syncthreads();
#pragma unroll
            for (int e2 = 0; e2 < 2; ++e2) { const int e = tid + e2 * 512; float s = 0.f;
#pragma unroll
                for (int w = 0; w < 8; ++w) s += red[w * 1024 + e];
                const int reg = e >> 6, ln = e & 63; const int row = rb * 32 + rowof(reg, ln >> 5), col = n0 + (ln & 31);
                if (row < NCR) MOD[((size_t)l * NCR + row) * NMOD + col] = s + a.in[9][(size_t)l * NMOD + col]; }
            __syncthreads();
        }
    }
}

__device__ __forceinline__ void phase_norm(const Args& a, int l, LAS unsigned char* lds, int tid, int lane, int wave, int G, int bid) {
    LAS float* Wg = (LAS float*)lds;
    const float* win = a.in[10] + (size_t)l * D * DIN;
    for (int k = tid; k < D; k += 512) { const f32x4 w0 = *(const f32x4*)(win + (size_t)k * DIN + 5120), w1 = *(const f32x4*)(win + (size_t)k * DIN + 5124);
        Wg[0 * D + k] = w0[0]; Wg[1 * D + k] = w0[1]; Wg[2 * D + k] = w0[2]; Wg[3 * D + k] = w0[3];
        Wg[4 * D + k] = w1[0]; Wg[5 * D + k] = w1[1]; Wg[6 * D + k] = w1[2]; Wg[7 * D + k] = w1[3]; }
    __syncthreads();
    const float* xp = l == 0 ? a.in[0] : (const float*)(a.ws + WS_X1);
    const float* xs = l == 0 ? a.in[1] : (const float*)(a.ws + WS_X1) + (size_t)MP * D;
    const float* gn = a.in[7] + (size_t)l * D;
    const float* MOD = (const float*)(a.ws + WS_MOD) + (size_t)l * NCR * NMOD;
    bf16_t* HN = (bf16_t*)(a.ws + WS_HN);
    float* IG = (float*)(a.ws + WS_IG); float* LF = (float*)(a.ws + WS_LF);
    for (int r = bid * 8 + wave; r < MT; r += G * 8) {
        const float* xr = (r < MP ? xp + (size_t)r * D : xs + (size_t)(r - MP) * D) + lane * 4;
        const int mrow = r < MP ? (r >> 11) : 4 + (r - MP);
        const float* mp = MOD + (size_t)mrow * NMOD + lane * 4;
        f32x4 v[8]; float ss = 0.f;
#pragma unroll
        for (int i = 0; i < 8; ++i) { v[i] = *(const f32x4*)(xr + 256 * i); ss += (v[i][0] * v[i][0] + v[i][1] * v[i][1]) + (v[i][2] * v[i][2] + v[i][3] * v[i][3]); }
        const float rstd = rsqrtf(wave_sum(ss) * (1.0f / D) + EPS);
        float gd[8];
#pragma unroll
        for (int j = 0; j < 8; ++j) gd[j] = 0.f;
#pragma unroll
        for (int i = 0; i < 8; ++i) {
            const f32x4 g = *(const f32x4*)(gn + lane * 4 + 256 * i), sh = *(const f32x4*)(mp + 256 * i), sc = *(const f32x4*)(mp + 2048 + 256 * i);
            const f32x4 hv = v[i] * rstd * g * (sc + 1.0f) + sh;
            u32x2 o; o.x = cvt_pk_bf16(hv[0], hv[1]); o.y = cvt_pk_bf16(hv[2], hv[3]);
            *(u32x2*)(HN + (size_t)r * D + lane * 4 + 256 * i) = o;
#pragma unroll
            for (int j = 0; j < 8; ++j) { const f32x4 w = *(const LAS f32x4*)(Wg + j * D + lane * 4 + 256 * i); gd[j] += (hv[0] * w[0] + hv[1] * w[1]) + (hv[2] * w[2] + hv[3] * w[3]); }
        }
#pragma unroll
        for (int j = 0; j < 8; ++j) gd[j] = wave_sum(gd[j]);
        if (lane < 4) {
            const float gi = lane == 0 ? gd[0] : lane == 1 ? gd[1] : lane == 2 ? gd[2] : gd[3];
            const float gf = lane == 0 ? gd[4] : lane == 1 ? gd[5] : lane == 2 ? gd[6] : gd[7];
            IG[r * 4 + lane] = gi + a.in[11][l * 4 + lane];
            const float f = gf + a.in[12][l * 4 + lane];
            LF[r * 4 + lane] = fminf(f, 0.f) - log1pf(expf(-fabsf(f)));
        }
    }
    __syncthreads();
}

__device__ __forceinline__ void chunk_scan(const float* IG, const float* LF, int r0, int h, int lane, float& b0, float& b1, float& e0, float& e1, float& cm0, float& cm1) {
    const float lf0 = LF[(r0 + 2 * lane) * 4 + h], lf1 = LF[(r0 + 2 * lane + 1) * 4 + h];
    const float ig0 = IG[(r0 + 2 * lane) * 4 + h], ig1 = IG[(r0 + 2 * lane + 1) * 4 + h];
    float s = lf0 + lf1;
#pragma unroll
    for (int o = 1; o < 64; o <<= 1) { const float t = __shfl_up(s, o); if (lane >= o) s += t; }
    b1 = s; b0 = s - lf1;
    e0 = ig0 - b0; e1 = ig1 - b1;
    float mx = fmaxf(e0, e1);
#pragma unroll
    for (int o = 1; o < 64; o <<= 1) { const float t = __shfl_up(mx, o); if (lane >= o) mx = fmaxf(mx, t); }
    cm1 = mx;
    const float prev = __shfl_up(mx, 1);
    cm0 = lane > 0 ? fmaxf(prev, e0) : e0;
}

__device__ __forceinline__ void scan_item(const Args& a, int l, int item, LAS unsigned char* lds, int tid, int lane, int wave) {
    const int bh = item >> 3, vt = (item >> 2) & 1, dt = item & 3, b = bh >> 2, h = bh & 3;
    LAS unsigned char* Vt = lds;
    LAS unsigned char* Kt = lds + 34816;
    LAS float* E = (LAS float*)(lds + 53248);
    LAS float* Gs = E + 2048;
    LAS float* Bc = Gs + 2048; LAS float* CMX = Bc + 16; LAS float* MC = CMX + 16; LAS float* DEC = MC + 32;
    const float* IG = (const float*)(a.ws + WS_IG); const float* LF = (const float*)(a.ws + WS_LF);
    const bf16_t* P = (const bf16_t*)(a.ws + WS_P);
    bf16_t* CST = (bf16_t*)(a.ws + WS_CST); float* NST = (float*)(a.ws + WS_NST); float* MST = (float*)(a.ws + WS_MST);
#pragma unroll
    for (int j = 0; j < 2; ++j) { const int cc = 2 * wave + j; float b0, b1, e0, e1, cm0, cm1;
        chunk_scan(IG, LF, b * 2048 + cc * 128, h, lane, b0, b1, e0, e1, cm0, cm1);
        E[cc * 128 + 2 * lane] = e0; E[cc * 128 + 2 * lane + 1] = e1;
        if (lane == 63) { Bc[cc] = b1; CMX[cc] = cm1; } }
    __syncthreads();
    if (tid == 0) { float m = 0.f;
        for (int cc = 0; cc < 16; ++cc) { MC[cc] = m; const float mn = Bc[cc] + fmaxf(m, CMX[cc]); DEC[cc] = __expf(Bc[cc] + m - mn); m = mn; }
        MC[16] = m; }
    __syncthreads();
    for (int t = tid; t < 2048; t += 512) { const int cc = t >> 7; Gs[t] = __expf(Bc[cc] + E[t] - MC[cc + 1]) * 0.0625f; }
    if (vt == 0 && dt == 0) { if (tid < 16) MST[bh * 16 + tid] = MC[tid]; if (tid == 0) a.out[OMP + l * 16 + bh] = MC[16]; }
    f32x16 acc = zero16(), nblk = zero16();
    const int vb = wave >> 1, db = wave & 1, r = lane & 31, hh = lane >> 5;
    const bool nwave = (vt == 0 && vb == 0);
    u32x4 vraw[4], kraw[2];
    { const int r0 = b * 2048;
#pragma unroll
      for (int i2 = 0; i2 < 4; ++i2) { const int i = tid + i2 * 512, s_ = i >> 4, ch = i & 15; vraw[i2] = *(const u32x4*)(P + (size_t)(r0 + s_) * NB + 2048 + h * 256 + vt * 128 + ch * 8); }
#pragma unroll
      for (int i2 = 0; i2 < 2; ++i2) { const int i = tid + i2 * 512, s_ = i >> 3, ch = i & 7; kraw[i2] = *(const u32x4*)(P + (size_t)(r0 + s_) * NB + 1024 + h * 256 + dt * 64 + ch * 8); } }
    for (int c = 0; c < 16; ++c) {
        { bf16_t* cp_ = CST + ((size_t)(bh * 16 + c) * 256 + vt * 128 + vb * 32 + r) * 256 + dt * 64 + db * 32 + 4 * hh;
#pragma unroll
          for (int q4 = 0; q4 < 4; ++q4) { u32x2 o; o.x = cvt_pk_bf16(acc[4 * q4 + 0], acc[4 * q4 + 1]); o.y = cvt_pk_bf16(acc[4 * q4 + 2], acc[4 * q4 + 3]); *(u32x2*)(cp_ + 8 * q4) = o; } }
        if (nwave && r == 0) {
#pragma unroll
            for (int reg = 0; reg < 16; ++reg) NST[(bh * 16 + c) * 256 + dt * 64 + db * 32 + rowof(reg, hh)] = nblk[reg]; }
        __syncthreads();
#pragma unroll
        for (int i2 = 0; i2 < 4; ++i2) { const int i = tid + i2 * 512, s_ = i >> 4, ch = i & 15;
            const u32x4 raw = vraw[i2]; const float g = Gs[c * 128 + s_];
            u32x4 o; o.x = cvt_pk_bf16(bflo(raw.x) * g, bfhi(raw.x) * g); o.y = cvt_pk_bf16(bflo(raw.y) * g, bfhi(raw.y) * g);
            o.z = cvt_pk_bf16(bflo(raw.z) * g, bfhi(raw.z) * g); o.w = cvt_pk_bf16(bflo(raw.w) * g, bfhi(raw.w) * g);
            *(LAS u32x4*)(Vt + s_ * 272 + ch * 16) = o; }
        if (tid < 128) { u32x4 o; o.x = cvt_pk_bf16(Gs[c * 128 + tid], 0.f); o.y = 0u; o.z = 0u; o.w = 0u; *(LAS u32x4*)(Vt + tid * 272 + 256) = o; }
#pragma unroll
        for (int i2 = 0; i2 < 2; ++i2) { const int i = tid + i2 * 512, s_ = i >> 3, ch = i & 7; *(LAS u32x4*)(Kt + s_ * 144 + ch * 16) = kraw[i2]; }
        if (c < 15) { const int r0 = b * 2048 + (c + 1) * 128;
#pragma unroll
            for (int i2 = 0; i2 < 4; ++i2) { const int i = tid + i2 * 512, s_ = i >> 4, ch = i & 15; vraw[i2] = *(const u32x4*)(P + (size_t)(r0 + s_) * NB + 2048 + h * 256 + vt * 128 + ch * 8); }
#pragma unroll
            for (int i2 = 0; i2 < 2; ++i2) { const int i = tid + i2 * 512, s_ = i >> 3, ch = i & 7; kraw[i2] = *(const u32x4*)(P + (size_t)(r0 + s_) * NB + 1024 + h * 256 + dt * 64 + ch * 8); } }
        __syncthreads();
        const float dec = DEC[c];
#pragma unroll
        for (int reg = 0; reg < 16; ++reg) { acc[reg] *= dec; nblk[reg] *= dec; }
        if (nwave) {
#pragma unroll
            for (int ks = 0; ks < 8; ++ks) { const bf16x8 vf = frag_tr(Vt, 272, ks * 16, vb * 32, lane); const bf16x8 kf = frag_tr(Kt, 144, ks * 16, db * 32, lane); const bf16x8 gf = frag_tr(Vt, 272, ks * 16, 128, lane);
                acc = mma32(kf, vf, acc); nblk = mma32(kf, gf, nblk); }
        } else {
#pragma unroll
            for (int ks = 0; ks < 8; ++ks) { const bf16x8 vf = frag_tr(Vt, 272, ks * 16, vb * 32, lane); const bf16x8 kf = frag_tr(Kt, 144, ks * 16, db * 32, lane); acc = mma32(kf, vf, acc); }
        }
    }
    { float* op_ = a.out + OCP + ((size_t)(l * 16 + bh) * 256 + vt * 128 + vb * 32 + r) * 256 + dt * 64 + db * 32 + 4 * hh;
#pragma unroll
      for (int q4 = 0; q4 < 4; ++q4) *(f32x4*)(op_ + 8 * q4) = (f32x4){acc[4 * q4 + 0], acc[4 * q4 + 1], acc[4 * q4 + 2], acc[4 * q4 + 3]}; }
    if (nwave && r == 0) {
#pragma unroll
        for (int reg = 0; reg < 16; ++reg) a.out[ONP + (l * 16 + bh) * 256 + dt * 64 + db * 32 + rowof(reg, hh)] = nblk[reg]; }
    __syncthreads();
}

__device__ __forceinline__ void mix_item(const Args& a, int l, int item, LAS unsigned char* lds, int tid, int lane, int wave) {
    const int b = item >> 6, c = (item >> 2) & 15, g = item & 3, r0 = b * 2048 + c * 128;
    LAS unsigned char* VN = lds;
    LAS unsigned char* WW = lds + 67584;
    const bf16_t* P = (const bf16_t*)(a.ws + WS_P);
    bf16_t* ACT = (bf16_t*)(a.ws + WS_ACT);
    const float* ws_ = a.in[15] + (size_t)(l * 4 + g) * 128 * 128;
#pragma unroll
    for (int i2 = 0; i2 < 8; ++i2) { const int i = tid + i2 * 512, t = i >> 5, s4 = (i & 31) * 4;
        f32x4 w = *(const f32x4*)(ws_ + t * 128 + s4);
        if (s4 + 0 > t) w[0] = 0.f; if (s4 + 1 > t) w[1] = 0.f; if (s4 + 2 > t) w[2] = 0.f; if (s4 + 3 > t) w[3] = 0.f;
        u32x2 o; o.x = cvt_pk_bf16(w[0], w[1]); o.y = cvt_pk_bf16(w[2], w[3]);
        *(LAS u32x2*)(WW + t * 272 + s4 * 2) = o; }
    const f32x4 gc = *(const f32x4*)(a.in[14] + l * 1024 + g * 256 + lane * 4);
    for (int i = 0; i < 16; ++i) { const int s = wave * 16 + i;
        const u32x2 raw = *(const u32x2*)(P + (size_t)(r0 + s) * NB + 6144 + g * 256 + lane * 4);
        float x0 = geluf_(bflo(raw.x)), x1 = geluf_(bfhi(raw.x)), x2 = geluf_(bflo(raw.y)), x3 = geluf_(bfhi(raw.y));
        const float mean = wave_sum((x0 + x1) + (x2 + x3)) * (1.0f / 256.0f);
        x0 -= mean; x1 -= mean; x2 -= mean; x3 -= mean;
        const float rstd = rsqrtf(wave_sum((x0 * x0 + x1 * x1) + (x2 * x2 + x3 * x3)) * (1.0f / 256.0f) + EPS);
        u32x2 o; o.x = cvt_pk_bf16(x0 * rstd * gc[0], x1 * rstd * gc[1]); o.y = cvt_pk_bf16(x2 * rstd * gc[2], x3 * rstd * gc[3]);
        *(LAS u32x2*)(VN + s * 528 + lane * 8) = o; }
    __syncthreads();
    const int tb = wave >> 1, cb0 = (wave & 1) * 4, r = lane & 31, hh = lane >> 5;
    f32x16 acc[4];
#pragma unroll
    for (int j = 0; j < 4; ++j) acc[j] = zero16();
    for (int ks = 0; ks < 2 * (tb + 1); ++ks) { const bf16x8 wf = frag_row(WW, 272, tb * 32, ks * 16, lane);
#pragma unroll
        for (int j = 0; j < 4; ++j) { const bf16x8 vf = frag_tr(VN, 528, ks * 16, (cb0 + j) * 32, lane); acc[j] = mma32(vf, wf, acc[j]); } }
    { const int t = tb * 32 + r; const float bias = a.in[16][(l * 4 + g) * 128 + t];
      const bf16_t* prow = P + (size_t)(r0 + t) * NB + g * 256 + 4 * hh; bf16_t* arow = ACT + (size_t)(r0 + t) * D + 1024 + g * 256 + 4 * hh;
#pragma unroll
      for (int j = 0; j < 4; ++j)
#pragma unroll
        for (int q4 = 0; q4 < 4; ++q4) { const int chb = (cb0 + j) * 32 + 8 * q4;
            const u32x2 ur = *(const u32x2*)(prow + 5120 + chb), zr = *(const u32x2*)(prow + 7168 + chb);
            const float o0 = geluf_(bflo(ur.x)) * (acc[j][4 * q4 + 0] + bias) * siluf_(bflo(zr.x)), o1 = geluf_(bfhi(ur.x)) * (acc[j][4 * q4 + 1] + bias) * siluf_(bfhi(zr.x));
            const float o2 = geluf_(bflo(ur.y)) * (acc[j][4 * q4 + 2] + bias) * siluf_(bflo(zr.y)), o3 = geluf_(bfhi(ur.y)) * (acc[j][4 * q4 + 3] + bias) * siluf_(bfhi(zr.y));
            u32x2 o; o.x = cvt_pk_bf16(o0, o1); o.y = cvt_pk_bf16(o2, o3); *(u32x2*)(arow + chb) = o; } }
    __syncthreads();
}

__device__ __forceinline__ void sample_item(const Args& a, int l, int item, LAS unsigned char* lds, int tid, int lane, int wave) {
    const int rr = item >> 2, h = item & 3, R = MP + rr;
    LAS float* q = (LAS float*)lds; LAS float* k = q + 256; LAS float* vv = q + 512; LAS float* n0 = q + 768; LAS float* CQ = q + 1024; LAS float* HH = q + 1280; LAS float* RED = q + 1536;
    const bf16_t* P = (const bf16_t*)(a.ws + WS_P);
    bf16_t* ACT = (bf16_t*)(a.ws + WS_ACT);
    const bf16_t* prow = P + (size_t)R * NB;
    const size_t sidx = (size_t)(l * 128 + rr) * 4 + h;
    if (tid < 256) { q[tid] = bf2f(prow[h * 256 + tid]); k[tid] = bf2f(prow[1024 + h * 256 + tid]) * 0.0625f; vv[tid] = bf2f(prow[2048 + h * 256 + tid]); n0[tid] = a.in[3][sidx * 256 + tid]; }
    __syncthreads();
    const float ig = ((const float*)(a.ws + WS_IG))[R * 4 + h], lf = ((const float*)(a.ws + WS_LF))[R * 4 + h], m0 = a.in[4][sidx];
    const float a_ = lf + m0, mt = fmaxf(a_, ig), wintra = __expf(ig - mt), winter = __expf(a_ - mt);
    const f32x4 q4 = *(const LAS f32x4*)(q + lane * 4), k4 = *(const LAS f32x4*)(k + lane * 4), n4 = *(const LAS f32x4*)(n0 + lane * 4);
    const float qk = wave_sum((q4[0] * k4[0] + q4[1] * k4[1]) + (q4[2] * k4[2] + q4[3] * k4[3]));
    const float nq = wave_sum((q4[0] * n4[0] + q4[1] * n4[1]) + (q4[2] * n4[2] + q4[3] * n4[3]));
    const float s = qk * wintra, den = winter * nq + s, inv = 1.0f / fmaxf(fabsf(den), __expf(-mt));
    const float* C0 = a.in[2] + sidx * 65536; float* C1 = a.out + OCS + sidx * 65536;
#pragma unroll 1
    for (int i0 = 0; i0 < 32; i0 += 16) {
        f32x4 c4[16];
#pragma unroll
        for (int i = 0; i < 16; ++i) c4[i] = __builtin_nontemporal_load((const f32x4*)(C0 + (size_t)(wave * 32 + i0 + i) * 256 + lane * 4));
#pragma unroll
        for (int i = 0; i < 16; ++i) { const int vrow = wave * 32 + i0 + i;
            float dot = (c4[i][0] * q4[0] + c4[i][1] * q4[1]) + (c4[i][2] * q4[2] + c4[i][3] * q4[3]);
            const float gv = wintra * vv[vrow];
            const f32x4 cn = c4[i] * winter + k4 * gv;
            __builtin_nontemporal_store(cn, (f32x4*)(C1 + (size_t)vrow * 256 + lane * 4));
            dot = wave_sum(dot); if (lane == 0) CQ[vrow] = dot; } }
    __syncthreads();
    float hv = 0.f, xg = 0.f;
    if (tid < 256) { const float num = winter * CQ[tid] + s * vv[tid]; hv = num * inv * sigmoidf_(bf2f(prow[3072 + h * 256 + tid])); HH[tid] = hv;
        a.out[ONS + sidx * 256 + tid] = winter * n0[tid] + wintra * k[tid];
        const float p = wave_sum(hv * hv); if (lane == 0) RED[wave] = p; }
    else { xg = geluf_(bf2f(prow[6144 + h * 256 + (tid - 256)])); const float p = wave_sum(xg); if (lane == 0) RED[wave] = p; }
    if (tid == 0) a.out[OMS + sidx] = mt;
    __syncthreads();
    if (tid < 256) { const float rstd = rsqrtf(((RED[0] + RED[1]) + (RED[2] + RED[3])) * (1.0f / 256.0f) + EPS);
        ACT[(size_t)R * D + h * 256 + tid] = f2bf(hv * rstd * a.in[13][l * 1024 + h * 256 + tid] * siluf_(bf2f(prow[4096 + h * 256 + tid]))); }
    else { const float mean = ((RED[4] + RED[5]) + (RED[6] + RED[7])) * (1.0f / 256.0f); xg -= mean; const float p = wave_sum(xg * xg); if (lane == 0) RED[4 + wave] = p; }
    __syncthreads();
    if (tid >= 256) { const int ch = tid - 256; const float rstd = rsqrtf(((RED[8] + RED[9]) + (RED[10] + RED[11])) * (1.0f / 256.0f) + EPS);
        const float vn = xg * rstd * a.in[14][l * 1024 + h * 256 + ch];
        a.out[OVS + (size_t)(l * 128 + rr) * 1024 + h * 256 + ch] = vn;
        const float w00 = a.in[15][(size_t)(l * 4 + h) * 16384], b0 = a.in[16][(l * 4 + h) * 128];
        ACT[(size_t)R * D + 1024 + h * 256 + ch] = f2bf(geluf_(bf2f(prow[5120 + h * 256 + ch])) * (w00 * vn + b0) * siluf_(bf2f(prow[7168 + h * 256 + ch]))); }
    __syncthreads();
}

__device__ __forceinline__ void mlstm_out_item(const Args& a, int l, int item, LAS unsigned char* lds, int tid, int lane, int wave) {
    const int bh = item >> 4, c = item & 15, b = bh >> 2, h = bh & 3, r0 = b * 2048 + c * 128;
    LAS unsigned char* KC = lds;
    LAS unsigned char* SS = lds + 67584;
    LAS unsigned char* VV = lds + 67584 + 34816;
    LAS float* SM = (LAS float*)(lds + 137216);
    LAS float* E = SM; LAS float* MX = SM + 128; LAS float* BT = SM + 256; LAS float* NQ = SM + 384; LAS float* INV = SM + 512; LAS float* WI = SM + 640; LAS float* SSQ = SM + 768; LAS float* NV = SM + 1024;
    const bf16_t* P = (const bf16_t*)(a.ws + WS_P);
    bf16_t* ACT = (bf16_t*)(a.ws + WS_ACT);
    const bf16_t* CST = (const bf16_t*)(a.ws + WS_CST) + (size_t)(bh * 16 + c) * 65536;
    const int tb = wave >> 1, sub = wave & 1, r = lane & 31, hh = lane >> 5;
    const float m_c = ((const float*)(a.ws + WS_MST))[bh * 16 + c];
    if (wave == 0) { float b0, b1, e0, e1, cm0, cm1;
        chunk_scan((const float*)(a.ws + WS_IG), (const float*)(a.ws + WS_LF), r0, h, lane, b0, b1, e0, e1, cm0, cm1);
        E[2 * lane] = e0; E[2 * lane + 1] = e1; MX[2 * lane] = fmaxf(m_c, cm0); MX[2 * lane + 1] = fmaxf(m_c, cm1); BT[2 * lane] = b0; BT[2 * lane + 1] = b1; }
    if (tid < 256) NV[tid] = ((const float*)(a.ws + WS_NST))[(bh * 16 + c) * 256 + tid];
#pragma unroll
    for (int i2 = 0; i2 < 8; ++i2) { const int i = tid + i2 * 512, s = i >> 5, ch = i & 31;
        *(LAS u32x4*)(KC + s * 528 + ch * 16) = *(const u32x4*)(P + (size_t)(r0 + s) * NB + 1024 + h * 256 + ch * 8); }
    bf16x8 qf[16];
    { const bf16_t* qrow = P + (size_t)(r0 + tb * 32 + r) * NB + h * 256 + 8 * hh;
#pragma unroll
      for (int ks = 0; ks < 16; ++ks) qf[ks] = *(const bf16x8*)(qrow + ks * 16); }
    __syncthreads();
    if (sub == 0) { float p = 0.f;
#pragma unroll
        for (int ks = 0; ks < 16; ++ks)
#pragma unroll
            for (int j = 0; j < 8; ++j) p += bf2f((bf16_t)qf[ks][j]) * NV[16 * ks + 8 * hh + j];
        p += __shfl_xor(p, 32); if (hh == 0) NQ[tb * 32 + r] = p; }
    const int t = tb * 32 + r;
#pragma unroll
    for (int jb = 0; jb < 2; ++jb) { const int sb = 2 * sub + jb;
        if (sb <= tb) { f32x16 acc = zero16();
#pragma unroll
            for (int ks = 0; ks < 16; ++ks) { const bf16x8 kf = frag_row(KC, 528, sb * 32, ks * 16, lane); acc = mma32(kf, qf[ks], acc); }
            const float mxt = MX[t];
#pragma unroll
            for (int q4 = 0; q4 < 4; ++q4) { const int s0 = sb * 32 + 8 * q4 + 4 * hh; const f32x4 e4 = *(const LAS f32x4*)(E + s0);
                const float w0 = (s0 + 0 <= t) ? __expf(e4[0] - mxt) * 0.0625f : 0.f, w1 = (s0 + 1 <= t) ? __expf(e4[1] - mxt) * 0.0625f : 0.f;
                const float w2 = (s0 + 2 <= t) ? __expf(e4[2] - mxt) * 0.0625f : 0.f, w3 = (s0 + 3 <= t) ? __expf(e4[3] - mxt) * 0.0625f : 0.f;
                u32x2 o; o.x = cvt_pk_bf16(acc[4 * q4 + 0] * w0, acc[4 * q4 + 1] * w1); o.y = cvt_pk_bf16(acc[4 * q4 + 2] * w2, acc[4 * q4 + 3] * w3);
                *(LAS u32x2*)(SS + t * 272 + s0 * 2) = o; } } }
    __syncthreads();
    f32x16 hval[2][2];
#pragma unroll
    for (int hv = 0; hv < 2; ++hv) {
        if (hv) __syncthreads();
#pragma unroll
        for (int i2 = 0; i2 < 4; ++i2) { const int i = tid + i2 * 512, s = i >> 4, ch = i & 15;
            *(LAS u32x4*)(VV + s * 272 + ch * 16) = *(const u32x4*)(P + (size_t)(r0 + s) * NB + 2048 + h * 256 + hv * 128 + ch * 8); }
#pragma unroll
        for (int i2 = 0; i2 < 8; ++i2) { const int i = tid + i2 * 512, v = i >> 5, ch = i & 31;
            *(LAS u32x4*)(KC + v * 528 + ch * 16) = *(const u32x4*)(CST + (size_t)(hv * 128 + v) * 256 + ch * 8); }
        if (hv == 0) { const int tt = tid >> 2, part = tid & 3; float sum = 0.f;
            if (part <= (tt >> 5)) {
#pragma unroll
                for (int j = 0; j < 4; ++j) { const u32x4 w = *(const LAS u32x4*)(SS + tt * 272 + part * 64 + j * 16);
                    sum += (bflo(w.x) + bfhi(w.x)) + (bflo(w.y) + bfhi(w.y)) + (bflo(w.z) + bfhi(w.z)) + (bflo(w.w) + bfhi(w.w)); } }
            sum += __shfl_xor(sum, 1); sum += __shfl_xor(sum, 2);
            if (part == 0) { const float wi = __expf(m_c - MX[tt]); const float den = wi * NQ[tt] + sum; const float mt = BT[tt] + MX[tt];
                INV[tt] = 1.0f / fmaxf(fabsf(den), __expf(-mt)); WI[tt] = wi; } }
        __syncthreads();
        const float wi = WI[t], inv = INV[t];
#pragma unroll
        for (int jb = 0; jb < 2; ++jb) { const int vb = 2 * sub + jb; f32x16 acc = zero16();
#pragma unroll
            for (int ks = 0; ks < 16; ++ks) { const bf16x8 cf = frag_row(KC, 528, vb * 32, ks * 16, lane); acc = mma32(cf, qf[ks], acc); }
#pragma unroll
            for (int reg = 0; reg < 16; ++reg) acc[reg] *= wi;
            for (int ks = 0; ks < 2 * (tb + 1); ++ks) { const bf16x8 sf = frag_row(SS, 272, tb * 32, ks * 16, lane); const bf16x8 vf = frag_tr(VV, 272, ks * 16, vb * 32, lane); acc = mma32(vf, sf, acc); }
            const bf16_t* orow = P + (size_t)(r0 + t) * NB + 3072 + h * 256 + hv * 128 + vb * 32 + 4 * hh;
#pragma unroll
            for (int q4 = 0; q4 < 4; ++q4) { const u32x2 raw = *(const u32x2*)(orow + 8 * q4);
                acc[4 * q4 + 0] *= inv * sigmoidf_(bflo(raw.x)); acc[4 * q4 + 1] *= inv * sigmoidf_(bfhi(raw.x));
                acc[4 * q4 + 2] *= inv * sigmoidf_(bflo(raw.y)); acc[4 * q4 + 3] *= inv * sigmoidf_(bfhi(raw.y)); }
            hval[hv][jb] = acc; }
    }
    { float s2 = 0.f;
#pragma unroll
      for (int reg = 0; reg < 16; ++reg) s2 += (hval[0][0][reg] * hval[0][0][reg] + hval[0][1][reg] * hval[0][1][reg]) + (hval[1][0][reg] * hval[1][0][reg] + hval[1][1][reg] * hval[1][1][reg]);
      s2 += __shfl_xor(s2, 32);
      if (hh == 0) SSQ[sub * 128 + t] = s2; }
    __syncthreads();
    { const float rstd = rsqrtf((SSQ[t] + SSQ[128 + t]) * (1.0f / 256.0f) + EPS);
      const float* gm = a.in[13] + l * 1024 + h * 256 + 4 * hh;
      const bf16_t* zrow = P + (size_t)(r0 + t) * NB + 4096 + h * 256 + 4 * hh; bf16_t* arow = ACT + (size_t)(r0 + t) * D + h * 256 + 4 * hh;
#pragma unroll
      for (int hv = 0; hv < 2; ++hv)
#pragma unroll
        for (int jb = 0; jb < 2; ++jb)
#pragma unroll
            for (int q4 = 0; q4 < 4; ++q4) { const int cb = hv * 128 + (2 * sub + jb) * 32 + 8 * q4;
                const u32x2 zr = *(const u32x2*)(zrow + cb); const f32x4 g4 = *(const f32x4*)(gm + cb);
                u32x2 o; o.x = cvt_pk_bf16(hval[hv][jb][4 * q4 + 0] * rstd * g4[0] * siluf_(bflo(zr.x)), hval[hv][jb][4 * q4 + 1] * rstd * g4[1] * siluf_(bfhi(zr.x)));
                o.y = cvt_pk_bf16(hval[hv][jb][4 * q4 + 2] * rstd * g4[2] * siluf_(bflo(zr.y)), hval[hv][jb][4 * q4 + 3] * rstd * g4[3] * siluf_(bfhi(zr.y)));
                *(u32x2*)(arow + cb) = o; } }
    __syncthreads();
}

__device__ __forceinline__ void phase_final(const Args& a, int tid, int lane, int wave, int G, int bid) {
    const float* gf = a.in[18];
    for (int r = bid * 8 + wave; r < MT; r += G * 8) {
        float* xr = a.out + OY + (size_t)r * D + lane * 4;
        f32x4 v[8]; float ss = 0.f;
#pragma unroll
        for (int i = 0; i < 8; ++i) { v[i] = *(const f32x4*)(xr + 256 * i); ss += (v[i][0] * v[i][0] + v[i][1] * v[i][1]) + (v[i][2] * v[i][2] + v[i][3] * v[i][3]); }
        const float rstd = rsqrtf(wave_sum(ss) * (1.0f / D) + EPS);
#pragma unroll
        for (int i = 0; i < 8; ++i) { const f32x4 g = *(const f32x4*)(gf + lane * 4 + 256 * i); *(f32x4*)(xr + 256 * i) = v[i] * rstd * g; }
    }
}

__global__ void __launch_bounds__(512, 2) fwd_megakernel(Args a) {
    extern __shared__ __attribute__((aligned(16))) unsigned char lds_raw[];
    LAS unsigned char* lds = (LAS unsigned char*)lds_raw;
    cg::grid_group grid = cg::this_grid();
    const int G = gridDim.x, bid = blockIdx.x;
    const int lo = a.ph_lo, hi = a.ph_hi;
#define IN(k) (lo <= (k) && (k) < hi)
#define SEAM(k) do { if (IN(k) && IN((k) + 1)) grid.sync(); } while (0)
#define TIDS int tid = threadIdx.x; asm volatile("" : "+v"(tid)); const int lane = tid & 63, wave = __builtin_amdgcn_readfirstlane(tid >> 6);
#define REPEAT(n) for (int rep_ = 0; rep_ < ((PROBE == (n)) ? 2 : 1); ++rep_)
#define RSYNC(n) do { if (PROBE == (n) && rep_ == 0) grid.sync(); } while (0)
    REPEAT(1) { if (IN(0)) { TIDS phase0(a, lds, tid, lane, wave, G, bid); } RSYNC(1); }
    SEAM(0);
    REPEAT(2) { if (IN(1)) { TIDS phase_ada(a, lds, tid, lane, wave, G, bid); } RSYNC(2); }
    SEAM(1);
#pragma unroll 1
    for (int l = 0; l < 2; ++l) {
        const int pb = 2 + 5 * l;
        REPEAT(3) { if (IN(pb)) { TIDS phase_norm(a, l, lds, tid, lane, wave, G, bid); } RSYNC(3); }
        SEAM(pb);
        REPEAT(4) { if (IN(pb + 1)) {
            pg8::Gemm g{(const bf16_t*)(a.ws + WS_HN), (const bf16_t*)(a.ws + WS_WIN) + (size_t)l * NB * D, MP, NB, D};
            pg8::StaticOrder S; S.init(MP, NB, G, bid);
            pg8::EpiP E{(bf16_t*)(a.ws + WS_P), NB};
            pg8::gemm_phase<pg8::EpiP, pg8::StaticOrder>(lds, g, S, E);
#pragma unroll 1
            for (int item = bid; item < 256; item += G) { TIDS skinny_item<0>(a, l, item * 32, (const bf16_t*)(a.ws + WS_HN) + (size_t)MP * D, (const bf16_t*)(a.ws + WS_WIN) + (size_t)l * NB * D, lds, tid, lane, wave); }
        } RSYNC(4); }
        SEAM(pb + 1);
        REPEAT(5) { if (IN(pb + 2)) {
#pragma unroll 1
            for (int item = bid; item < 896; item += G) { TIDS
                if (item < 128) scan_item(a, l, item, lds, tid, lane, wave);
                else if (item < 384) mix_item(a, l, item - 128, lds, tid, lane, wave);
                else sample_item(a, l, item - 384, lds, tid, lane, wave);
            }
        } RSYNC(5); }
        SEAM(pb + 2);
        REPEAT(6) { if (IN(pb + 3)) {
#pragma unroll 1
            for (int item = bid; item < 256; item += G) { TIDS mlstm_out_item(a, l, item, lds, tid, lane, wave); }
        } RSYNC(6); }
        SEAM(pb + 3);
        REPEAT(7) { if (IN(pb + 4)) {
            pg8::Gemm g{(const bf16_t*)(a.ws + WS_ACT), (const bf16_t*)(a.ws + WS_WOUT) + (size_t)l * D * D, MP, D, D};
            pg8::StaticOrder S; S.init(MP, D, G, bid);
            pg8::EpiRes E{l == 0 ? a.in[0] : (const float*)(a.ws + WS_X1), l == 0 ? a.in[1] : (const float*)(a.ws + WS_X1) + (size_t)MP * D,
                          l == 0 ? (float*)(a.ws + WS_X1) : a.out + OY, (const float*)(a.ws + WS_MOD) + (size_t)l * NCR * NMOD};
            pg8::gemm_phase<pg8::EpiRes, pg8::StaticOrder>(lds, g, S, E);
#pragma unroll 1
            for (int item = bid; item < 64; item += G) { TIDS skinny_item<1>(a, l, item * 32, (const bf16_t*)(a.ws + WS_ACT) + (size_t)MP * D, (const bf16_t*)(a.ws + WS_WOUT) + (size_t)l * D * D, lds, tid, lane, wave); }
        } RSYNC(7); }
        SEAM(pb + 4);
    }
    if (IN(12)) { TIDS phase_final(a, tid, lane, wave, G, bid); }
#undef TIDS
#undef IN
#undef SEAM
}

#ifndef N_LAUNCH_MODE
#define N_LAUNCH_MODE 1
#endif

extern "C" void kernel_launch(void* const* d_in, const int* in_sizes, int n_in, void* d_out, int out_size, void* d_ws, size_t ws_size, hipStream_t stream) {
    static int grid = 0;
    if (grid == 0) {
        int dev = 0, cus = 0, per_cu = 0;
        hipGetDevice(&dev);
        hipDeviceGetAttribute(&cus, hipDeviceAttributeMultiprocessorCount, dev);
        hipFuncSetAttribute((const void*)fwd_megakernel, hipFuncAttributeMaxDynamicSharedMemorySize, LDS_BYTES);
        hipOccupancyMaxActiveBlocksPerMultiprocessor(&per_cu, (const void*)fwd_megakernel, 512, LDS_BYTES);
        if (per_cu < 1) { fprintf(stderr, "occupancy query returned %d\n", per_cu); per_cu = 1; }
        grid = cus * per_cu;
        if (n_in != 19 || ws_size < WS_END) { fprintf(stderr, "unexpected n_in %d / ws %zu\n", n_in, ws_size); }
    }
    Args a{};
    for (int i = 0; i < 19; ++i) a.in[i] = (const float*)d_in[i];
    a.out = (float*)d_out; a.ws = (unsigned char*)d_ws;
#if N_LAUNCH_MODE == 1
    a.ph_lo = 0; a.ph_hi = NPHASE;
    void* args[] = {&a};
    hipError_t e = hipLaunchCooperativeKernel((const void*)fwd_megakernel, dim3(grid), dim3(512), args, LDS_BYTES, stream);
    if (e != hipSuccess) fprintf(stderr, "cooperative launch failed: %s (grid %d)\n", hipGetErrorString(e), grid);
#else
    for (int p = 0; p < NPHASE; ++p) {
        a.ph_lo = p; a.ph_hi = p + 1;
        void* args[] = {&a};
        hipError_t e = hipLaunchCooperativeKernel((const void*)fwd_megakernel, dim3(grid), dim3(512), args, LDS_BYTES, stream);
        if (e != hipSuccess) { fprintf(stderr, "launch %d failed: %s (grid %d)\n", p, hipGetErrorString(e), grid); break; }
    }
#endif
}
```

```cpp
#include <hip/hip_runtime.h>
#include <hip/hip_cooperative_groups.h>
#include <cstdio>
namespace cg = cooperative_groups;

#define LAS __attribute__((address_space(3)))
typedef unsigned short bf16_t;
typedef short bf16x8 __attribute__((ext_vector_type(8)));
typedef short s16x4 __attribute__((ext_vector_type(4)));
typedef float f32x4 __attribute__((ext_vector_type(4)));
typedef float f32x16 __attribute__((ext_vector_type(16)));
typedef unsigned u32x4 __attribute__((ext_vector_type(4)));
typedef unsigned u32x2 __attribute__((ext_vector_type(2)));

constexpr int D = 2048, MP = 8192, MS = 128, MT = 8320, MPAD = 8448;
constexpr int NB = 8192, DIN = 8200, NMOD = 6144, NCR = 132;
constexpr float EPS = 1e-6f;
constexpr size_t OY = 0, OCP = 17039360, ONP = 19136512, OMP = 19144704, OCS = 19144736, ONS = 86253600, OMS = 86515744, OVS = 86516768;
constexpr size_t MiB = 1u << 20;
constexpr size_t WS_WIN = 1 * MiB;
constexpr size_t WS_WOUT = 65 * MiB;
constexpr size_t WS_SC = 81 * MiB;
constexpr size_t WS_MOD = 82 * MiB;
constexpr size_t WS_HN = 90 * MiB;
constexpr size_t WS_P = 123 * MiB;
constexpr size_t WS_IG = 255 * MiB;
constexpr size_t WS_LF = 255 * MiB + 512 * 1024;
constexpr size_t WS_X1 = 256 * MiB;
constexpr size_t WS_ACT = 321 * MiB;
constexpr size_t WS_CST = 354 * MiB;
constexpr size_t WS_NST = 386 * MiB;
constexpr size_t WS_MST = 386 * MiB + 512 * 1024;
constexpr size_t WS_END = 387 * MiB;
constexpr int LDS_BYTES = 155648;
constexpr int NPHASE = 13;
#ifndef PROBE
#define PROBE 0
#endif

struct Args { const float* in[19]; float* out; unsigned char* ws; int ph_lo, ph_hi; };

__device__ __forceinline__ float bf2f(bf16_t b) { return __uint_as_float(((unsigned)b) << 16); }
__device__ __forceinline__ float bflo(unsigned w) { return __uint_as_float(w << 16); }
__device__ __forceinline__ float bfhi(unsigned w) { return __uint_as_float(w & 0xffff0000u); }
__device__ __forceinline__ unsigned cvt_pk_bf16(float lo, float hi) { unsigned r; asm volatile("v_cvt_pk_bf16_f32 %0, %1, %2" : "=v"(r) : "v"(lo), "v"(hi)); return r; }
__device__ __forceinline__ bf16_t f2bf(float f) { return (bf16_t)(cvt_pk_bf16(f, 0.f) & 0xffffu); }
__device__ __forceinline__ float sigmoidf_(float x) { return 1.0f / (1.0f + __expf(-x)); }
__device__ __forceinline__ float siluf_(float x) { return x / (1.0f + __expf(-x)); }
__device__ __forceinline__ float geluf_(float x) { const float u = 1.5957691216f * (x + 0.044715f * x * x * x); return x / (1.0f + __expf(-u)); }
__device__ __forceinline__ float wave_sum(float v) {
#pragma unroll
    for (int o = 1; o < 64; o <<= 1) v += __shfl_xor(v, o);
    return v;
}
__device__ __forceinline__ int rowof(int reg, int hh) { return (reg & 3) + 8 * (reg >> 2) + 4 * hh; }
__device__ __forceinline__ bf16x8 frag_row(const LAS unsigned char* base, int ldb, int row0, int k0, int lane) {
    return *(const LAS bf16x8*)(base + (row0 + (lane & 31)) * ldb + (k0 + 8 * (lane >> 5)) * 2);
}
__device__ __forceinline__ bf16x8 frag_tr(const LAS unsigned char* base, int ldb, int k0, int n0, int lane) {
    const int hh = lane >> 5, blk = (lane >> 4) & 1, q = (lane & 15) >> 2, p = lane & 3;
    const LAS unsigned char* a = base + (k0 + 8 * hh + q) * ldb + (n0 + 16 * blk + 4 * p) * 2;
    const s16x4 lo = __builtin_amdgcn_ds_read_tr16_b64_v4i16((LAS s16x4*)a);
    const s16x4 hi = __builtin_amdgcn_ds_read_tr16_b64_v4i16((LAS s16x4*)(a + 4 * ldb));
    return (bf16x8){lo[0], lo[1], lo[2], lo[3], hi[0], hi[1], hi[2], hi[3]};
}
__device__ __forceinline__ f32x16 mma32(bf16x8 a, bf16x8 b, f32x16 c) { return __builtin_amdgcn_mfma_f32_32x32x16_bf16(a, b, c, 0, 0, 0); }
__device__ __forceinline__ f32x16 zero16() { f32x16 z;
#pragma unroll
    for (int i = 0; i < 16; ++i) z[i] = 0.f;
    return z; }

#define XB_TMO      128
#define XB_XCNT(j)  (256  + 64 * (j))
#define XB_XSUB(j)  (1280 + 64 * (j))
#define XB_XGEN(j)  (2304 + 64 * (j))
#define XB_TOP      3328
#define XB_TOPGEN   3392
#define XCD_BAR_WORDS 3456
#define XB_SPIN_CAP (1u << 18)
__device__ __forceinline__ unsigned xb_ld(unsigned* p)              { return __hip_atomic_load(p, __ATOMIC_RELAXED, __HIP_MEMORY_SCOPE_AGENT); }
__device__ __forceinline__ unsigned xb_add(unsigned* p, unsigned v) { return __hip_atomic_fetch_add(p, v, __ATOMIC_RELAXED, __HIP_MEMORY_SCOPE_AGENT); }
__device__ __forceinline__ unsigned xb_xcc_id() { return (unsigned)__builtin_amdgcn_s_getreg((3 << 11) | 20) & 0xFu; }
#define XB_SPIN(cond, bar) do { unsigned _sp = 0; while (cond) { __builtin_amdgcn_s_sleep(1); \
    if ((++_sp & 255u) == 0u) { if (xb_ld(&(bar)[XB_TMO])) break; if (_sp > XB_SPIN_CAP) { atomicAdd(&(bar)[XB_TMO], 1u); break; } } } } while (0)
struct XcdBarrier { unsigned* bar; unsigned x; volatile LAS unsigned* st; };
__device__ __forceinline__ XcdBarrier xcd_barrier_post(unsigned* bar, volatile LAS unsigned* st) {
    XcdBarrier b; b.bar = bar; b.x = xb_xcc_id(); b.st = st;
    if (threadIdx.x == 0) (void)xb_add(&bar[XB_XCNT(b.x)], 1u);
    return b;
}
__device__ __forceinline__ void xcd_barrier_complete(unsigned* bar, unsigned x, unsigned& nloc, unsigned& nx) {
    const unsigned G = gridDim.x * gridDim.y * gridDim.z;
    unsigned sum, cnt, mine, sp = 0u;
    for (;;) {
        sum = 0u; cnt = 0u; mine = 0u;
#pragma unroll
        for (unsigned j = 0; j < 16; ++j) { const unsigned c = xb_ld(&bar[XB_XCNT(j)]); sum += c; cnt += (c > 0u) ? 1u : 0u; mine = (j == x) ? c : mine; }
        if (sum == G) break;
        __builtin_amdgcn_s_sleep(1);
        if ((++sp & 255u) == 0u) { if (xb_ld(&bar[XB_TMO])) break; if (sp > XB_SPIN_CAP) { atomicAdd(&bar[XB_TMO], 1u); break; } }
    }
    nloc = mine > 0u ? mine : 1u; nx = cnt > 0u ? cnt : 1u;
}
__device__ __forceinline__ void xcd_barrier(const XcdBarrier& b) {
    asm volatile("s_waitcnt vmcnt(0)" ::: "memory");
    __syncthreads();
    if (threadIdx.x == 0) {
        unsigned* bar = b.bar;
        __builtin_amdgcn_s_waitcnt(0);
        unsigned nloc = b.st[0], nx = b.st[1];
        if (nloc == 0u) { xcd_barrier_complete(bar, b.x, nloc, nx); b.st[0] = nloc; b.st[1] = nx; }
        const unsigned old = xb_add(&bar[XB_XSUB(b.x)], 1u);
        const unsigned gen = old / nloc;
        if (old + 1u == (gen + 1u) * nloc) {
            __builtin_amdgcn_fence(__ATOMIC_RELEASE, "agent");
            asm volatile("s_waitcnt vmcnt(0)" ::: "memory");
            const unsigned og = xb_add(&bar[XB_TOP], 1u);
            const unsigned tg = og / nx;
            if (og + 1u == (tg + 1u) * nx) xb_add(&bar[XB_TOPGEN], 1u);
            else XB_SPIN(xb_ld(&bar[XB_TOPGEN]) == tg, bar);
            __builtin_amdgcn_fence(__ATOMIC_ACQUIRE, "agent");
            xb_add(&bar[XB_XGEN(b.x)], 1u);
            asm volatile("s_waitcnt vmcnt(0)" ::: "memory");
        } else {
            XB_SPIN(xb_ld(&bar[XB_XGEN(b.x)]) == gen, bar);
            __builtin_amdgcn_fence(__ATOMIC_ACQUIRE, "agent");
            asm volatile("s_waitcnt vmcnt(0)" ::: "memory");
        }
    }
    __syncthreads();
}

namespace pg8 {
constexpr int BM = 256, BK = 64, HALF = 128, HTB = HALF * BK * 2, STAGE_BYTES = 8 * HTB, NXCD = 8, WGM = 8;
__device__ __forceinline__ int lds_byte(int r, int c) { const int st = (r >> 4) * 2 + (c >> 5), rr = r & 15, cc = c & 31, ob = rr * 64 + cc * 2; return st * 1024 + (ob ^ (((ob >> 9) & 1) << 5)); }
__device__ __forceinline__ void stage_rc(int b, int& R, int& C) { const int st = b / 1024, sb = b % 1024, swz = sb ^ (((sb >> 9) & 1) << 5); R = (st >> 1) * 16 + swz / 64; C = (st & 1) * 32 + (swz % 64) / 2; }
__device__ __forceinline__ int perm32(int rho) { const int n = rho >> 4, i = rho & 15; return 8 * (i >> 2) + 4 * n + (i & 3); }
struct Unit { int pm, pn; };
struct Gemm { const bf16_t* A; const bf16_t* Bt; int M, N, K; };
struct StaticOrder {
    int nM, nN, nwg, G, c;
    __device__ void init(int M, int N, int G_, int c_) { nM = M / BM; nN = N / BM; nwg = nM * nN; G = G_; c = c_; }
    __device__ bool next(int i, Unit& u) const {
        const long L = (long)i * G + c; if (L >= nwg) return false;
        int wgid = (int)L; { const int q = nwg / NXCD, r = nwg % NXCD, xcd = wgid % NXCD, off = wgid / NXCD; wgid = (xcd < r ? xcd * (q + 1) : r * (q + 1) + (xcd - r) * q) + off; }
        const int nig = WGM * nN, gid = wgid / nig, fm = gid * WGM, gsz = (nM - fm) < WGM ? (nM - fm) : WGM;
        u.pm = fm + ((wgid % nig) % gsz); u.pn = (wgid % nig) / gsz; return true;
    }
};
struct EpiP {
    static constexpr bool PERM = true;
    bf16_t* O; int ldc;
    __device__ __forceinline__ void operator()(const f32x4 (&acc)[2][2][4][2], const Unit& u, int wr, int wc, int fr, int fq) const {
        const int row0 = u.pm * BM + wr * 64 + fr, col0 = u.pn * BM + wc * 32 + 8 * fq;
#pragma unroll
        for (int ai = 0; ai < 2; ++ai)
#pragma unroll
            for (int m = 0; m < 4; ++m) { bf16_t* rowp = O + (size_t)(row0 + ai * HALF + m * 16) * ldc + col0;
#pragma unroll
                for (int bj = 0; bj < 2; ++bj) { const f32x4 v0 = acc[ai][bj][m][0], v1 = acc[ai][bj][m][1];
                    u32x4 w; w.x = cvt_pk_bf16(v0[0], v0[1]); w.y = cvt_pk_bf16(v0[2], v0[3]); w.z = cvt_pk_bf16(v1[0], v1[1]); w.w = cvt_pk_bf16(v1[2], v1[3]);
                    *(u32x4*)(rowp + bj * HALF) = w; } }
    }
};
struct EpiRes {
    static constexpr bool PERM = false;
    const float* xp; const float* xs; float* dst; const float* mod;
    __device__ __forceinline__ void operator()(const f32x4 (&acc)[2][2][4][2], const Unit& u, int wr, int wc, int fr, int fq) const {
        const int row0 = u.pm * BM + wr * 64 + fr, col0 = u.pn * BM + wc * 32 + 4 * fq;
#pragma unroll
        for (int ai = 0; ai < 2; ++ai)
#pragma unroll
            for (int m = 0; m < 4; ++m) { const int r = row0 + ai * HALF + m * 16;
                if (r < MT) {
                    const int mrow = r < MP ? (r >> 11) : 4 + (r - MP);
                    const float* xo = (r < MP ? xp + (size_t)r * D : xs + (size_t)(r - MP) * D) + col0;
                    const float* gp = mod + (size_t)mrow * NMOD + 4096 + col0;
                    float* dp = dst + (size_t)r * D + col0;
#pragma unroll
                    for (int bj = 0; bj < 2; ++bj)
#pragma unroll
                        for (int n = 0; n < 2; ++n) { const f32x4 g = *(const f32x4*)(gp + bj * HALF + n * 16); const f32x4 x = *(const f32x4*)(xo + bj * HALF + n * 16);
                            *(f32x4*)(dp + bj * HALF + n * 16) = x + g * acc[ai][bj][m][n]; } } }
    }
};

template <class Epi, class Sched>
__device__ __forceinline__ void gemm_phase(LAS unsigned char* lds, const Gemm g, const Sched& S, const Epi& E) {
    int tid = threadIdx.x; asm volatile("" : "+v"(tid));
    const int wid = __builtin_amdgcn_readfirstlane(tid >> 6), lane = tid & 63, wr = wid >> 2, wc = wid & 3, fr = lane & 15, fq = lane >> 4;
    const int K = g.K, nt = K / BK;
    unsigned voffA[2], voffB[2];
#pragma unroll
    for (int i = 0; i < 2; ++i) { int R, C; stage_rc(tid * 16 + i * 8192, R, C); const int Rb = Epi::PERM ? ((R & ~31) + perm32(R & 31)) : R;
        voffA[i] = (unsigned)(R * K + C) * 2u; voffB[i] = (unsigned)(Rb * K + C) * 2u; }
    const size_t kstep = (size_t)(BK * 2);
    const size_t hstep = (size_t)HALF * K * 2;
    const size_t tstep = 2 * hstep;
    const unsigned ldsw = (unsigned)wid * 1024u;
    const int aoff = lds_byte(wr * 64 + fr, fq * 8), boff = lds_byte(wc * 32 + fr, fq * 8);
#define PG8_SA(b, h) (((b) * 2 + (h)) * HTB)
#define PG8_SB(b, h) ((4 + (b) * 2 + (h)) * HTB)
#define PG8_STAGE(bufoff, gbase, voff) do { _Pragma("unroll") for (int _i = 0; _i < 2; ++_i) \
        __builtin_amdgcn_global_load_lds((const unsigned*)((const char*)(gbase) + (voff)[_i]), (LAS unsigned*)(lds + (bufoff) + ldsw + _i * 8192), 16, 0, 0); } while (0)
#define PG8_LDA(dst, b, h) do { _Pragma("unroll") for (int m = 0; m < 4; ++m) _Pragma("unroll") for (int k = 0; k < 2; ++k) dst[m][k] = *(const LAS bf16x8*)(lds + PG8_SA(b, h) + aoff + m * 2048 + k * 1024); } while (0)
#define PG8_LDB(dst, b, h) do { _Pragma("unroll") for (int n = 0; n < 2; ++n) _Pragma("unroll") for (int k = 0; k < 2; ++k) dst[n][k] = *(const LAS bf16x8*)(lds + PG8_SB(b, h) + boff + n * 2048 + k * 1024); } while (0)
#define PG8_MMA(ai, bj, At, Bt) do { __builtin_amdgcn_s_setprio(1); _Pragma("unroll") for (int m = 0; m < 4; ++m) _Pragma("unroll") for (int n = 0; n < 2; ++n) _Pragma("unroll") for (int k = 0; k < 2; ++k) \
        acc[ai][bj][m][n] = __builtin_amdgcn_mfma_f32_16x16x32_bf16(Bt[n][k], At[m][k], acc[ai][bj][m][n], 0, 0, 0); __builtin_amdgcn_s_setprio(0); } while (0)
#define PG8_WAIT_V(n) asm volatile("s_waitcnt vmcnt(" #n ")" ::: "memory")
#define PG8_WAIT_L(n) asm volatile("s_waitcnt lgkmcnt(" #n ")" ::: "memory")
#define PG8_BAR __builtin_amdgcn_s_barrier()
#define PG8_SCHED __builtin_amdgcn_sched_barrier(0)
    Unit cur, nxt; int ui = 0;
    if (!S.next(0, cur)) return;
    f32x4 acc[2][2][4][2];
#pragma unroll
    for (int a = 0; a < 2; ++a)
#pragma unroll
        for (int b = 0; b < 2; ++b)
#pragma unroll
            for (int m = 0; m < 4; ++m)
#pragma unroll
                for (int n = 0; n < 2; ++n) acc[a][b][m][n] = (f32x4){0.f, 0.f, 0.f, 0.f};
    bf16x8 At[4][2], B0[2][2], B1[2][2];
    const char* cA = (const char*)g.A + (size_t)cur.pm * tstep; const char* cB = (const char*)g.Bt + (size_t)cur.pn * tstep;
    PG8_STAGE(PG8_SB(0, 0), cB, voffB); PG8_STAGE(PG8_SA(0, 0), cA, voffA); PG8_STAGE(PG8_SB(0, 1), cB + hstep, voffB); PG8_STAGE(PG8_SA(0, 1), cA + hstep, voffA);
    if (wr == 1) PG8_BAR;
    PG8_WAIT_V(4); PG8_BAR;
    PG8_STAGE(PG8_SB(1, 0), cB + kstep, voffB); PG8_STAGE(PG8_SA(1, 0), cA + kstep, voffA); PG8_STAGE(PG8_SB(1, 1), cB + hstep + kstep, voffB);
    PG8_WAIT_V(6); PG8_BAR;
    for (;;) {
        const bool has_next = S.next(ui + 1, nxt);
        const char* nA = has_next ? (const char*)g.A + (size_t)nxt.pm * tstep : cA; const char* nB = has_next ? (const char*)g.Bt + (size_t)nxt.pn * tstep : cB;
        for (int t = 0; t < nt; t += 2) {
            const bool last = (t == nt - 2);
            const char* a1 = cA + (size_t)(t + 1) * kstep;
            const char* a2 = last ? nA : cA + (size_t)(t + 2) * kstep; const char* b2 = last ? nB : cB + (size_t)(t + 2) * kstep;
            const char* a3 = a2 + kstep; const char* b3 = b2 + kstep;
            PG8_LDB(B0, 0, 0); PG8_SCHED; PG8_LDA(At, 0, 0); PG8_STAGE(PG8_SA(1, 1), a1 + hstep, voffA);
            PG8_WAIT_L(8); PG8_BAR; PG8_WAIT_L(0); PG8_MMA(0, 0, At, B0); PG8_BAR; PG8_SCHED;
            PG8_LDB(B1, 0, 1); PG8_STAGE(PG8_SB(0, 0), b2, voffB);
            PG8_BAR; PG8_WAIT_L(0); PG8_MMA(0, 1, At, B1); PG8_BAR;
            PG8_LDA(At, 0, 1); PG8_STAGE(PG8_SA(0, 0), a2, voffA);
            PG8_BAR; PG8_WAIT_L(0); PG8_MMA(1, 0, At, B0); PG8_BAR; PG8_SCHED;
            PG8_STAGE(PG8_SB(0, 1), b2 + hstep, voffB);
            PG8_WAIT_V(6); PG8_BAR; PG8_MMA(1, 1, At, B1); PG8_BAR;
            PG8_LDB(B0, 1, 0); PG8_SCHED; PG8_LDA(At, 1, 0); PG8_STAGE(PG8_SA(0, 1), a2 + hstep, voffA);
            PG8_WAIT_L(8); PG8_BAR; PG8_WAIT_L(0); PG8_MMA(0, 0, At, B0); PG8_BAR; PG8_SCHED;
            PG8_LDB(B1, 1, 1); PG8_STAGE(PG8_SB(1, 0), b3, voffB);
            PG8_BAR; PG8_WAIT_L(0); PG8_MMA(0, 1, At, B1); PG8_BAR;
            PG8_LDA(At, 1, 1); PG8_STAGE(PG8_SA(1, 0), a3, voffA);
            PG8_BAR; PG8_WAIT_L(0); PG8_MMA(1, 0, At, B0); PG8_BAR; PG8_SCHED;
            PG8_STAGE(PG8_SB(1, 1), b3 + hstep, voffB);
            PG8_WAIT_V(6); PG8_BAR; PG8_MMA(1, 1, At, B1); PG8_BAR;
        }
        E(acc, cur, wr, wc, fr, fq);
        if (!has_next) break;
#pragma unroll
        for (int a = 0; a < 2; ++a)
#pragma unroll
            for (int b = 0; b < 2; ++b)
#pragma unroll
                for (int m = 0; m < 4; ++m)
#pragma unroll
                    for (int n = 0; n < 2; ++n) acc[a][b][m][n] = (f32x4){0.f, 0.f, 0.f, 0.f};
        cur = nxt; cA = nA; cB = nB; ++ui;
    }
    PG8_WAIT_V(0);
    if (wr == 0) PG8_BAR;
    PG8_BAR;
#undef PG8_SA
#undef PG8_SB
#undef PG8_STAGE
#undef PG8_LDA
#undef PG8_LDB
#undef PG8_MMA
#undef PG8_WAIT_V
#undef PG8_WAIT_L
#undef PG8_BAR
#undef PG8_SCHED
}
}

template <int MODE>
__device__ __forceinline__ void skinny_item(const Args& a, int l, int n0, const bf16_t* Arows, const bf16_t* Bt, LAS unsigned char* lds, int tid, int lane, int wave) {
    LAS float* red = (LAS float*)lds;
    const int r = lane & 31, hh = lane >> 5;
    f32x16 acc[4];
#pragma unroll
    for (int i = 0; i < 4; ++i) acc[i] = zero16();
    const bf16_t* bp = Bt + (size_t)(n0 + r) * D + wave * 256 + 8 * hh;
    const bf16_t* ap = Arows + (size_t)r * D + wave * 256 + 8 * hh;
#pragma unroll 4
    for (int ks = 0; ks < 16; ++ks) { const bf16x8 bf = *(const bf16x8*)(bp + ks * 16);
#pragma unroll
        for (int rb = 0; rb < 4; ++rb) { const bf16x8 af = *(const bf16x8*)(ap + (size_t)rb * 32 * D + ks * 16); acc[rb] = mma32(bf, af, acc[rb]); } }
#pragma unroll
    for (int rb = 0; rb < 4; ++rb)
#pragma unroll
        for (int reg = 0; reg < 16; ++reg) red[((wave * 4 + rb) * 16 + reg) * 64 + lane] = acc[rb][reg];
    __syncthreads();
#pragma unroll
    for (int i = 0; i < 8; ++i) { const int e = tid + 512 * i; float sum = 0.f;
#pragma unroll
        for (int w = 0; w < 8; ++w) sum += red[w * 4096 + e];
        const int rb = e >> 10, reg = (e >> 6) & 15, ln = e & 63; const int m = rb * 32 + (ln & 31), n = n0 + rowof(reg, ln >> 5);
        if (MODE == 0) ((bf16_t*)(a.ws + WS_P))[(size_t)(MP + m) * NB + n] = f2bf(sum);
        else { const float* xs = l == 0 ? a.in[1] : (const float*)(a.ws + WS_X1) + (size_t)MP * D; float* dst = (l == 0 ? (float*)(a.ws + WS_X1) : a.out + OY) + (size_t)MP * D;
            const float gate = ((const float*)(a.ws + WS_MOD))[((size_t)l * NCR + 4 + m) * NMOD + 4096 + n];
            dst[(size_t)m * D + n] = xs[(size_t)m * D + n] + gate * sum; } }
    __syncthreads();
}

__device__ __forceinline__ void transpose_item(const float* W, int ldw, int nblk, bf16_t* WT, int K, int item, bool remap, LAS float* scr, int lane) {
    const int kb = item / nblk, nb = item % nblk, k0 = 64 * kb, n0 = 32 * nb;
    const int n0s = (remap && n0 >= 5120) ? n0 + 8 : n0;
#pragma unroll 8
    for (int i = 0; i < 32; ++i) { const int kk = 2 * i + (lane >> 5); scr[kk * 33 + (lane & 31)] = W[(size_t)(k0 + kk) * ldw + n0s + (lane & 31)]; }
    asm volatile("s_waitcnt lgkmcnt(0)" ::: "memory");
    const int c = lane & 7;
#pragma unroll
    for (int j = 0; j < 4; ++j) { const int n = (lane >> 3) + 8 * j; const LAS float* s = scr + (8 * c) * 33 + n;
        u32x4 o; o.x = cvt_pk_bf16(s[0 * 33], s[1 * 33]); o.y = cvt_pk_bf16(s[2 * 33], s[3 * 33]); o.z = cvt_pk_bf16(s[4 * 33], s[5 * 33]); o.w = cvt_pk_bf16(s[6 * 33], s[7 * 33]);
        *(u32x4*)(WT + (size_t)(n0 + n) * K + k0 + 8 * c) = o; }
    asm volatile("s_waitcnt lgkmcnt(0)" ::: "memory");
}
__device__ __forceinline__ void phase0(const Args& a, LAS unsigned char* lds, int tid, int lane, int wave, int G, int bid) {
    bf16_t* SC = (bf16_t*)(a.ws + WS_SC);
    const float* cp = a.in[5]; const float* cs = a.in[6];
    for (int i = bid * 512 + tid; i < 160 * 512; i += G * 512) {
        const int r = i >> 9, c4 = (i & 511) * 4;
        f32x4 v = (f32x4){0.f, 0.f, 0.f, 0.f};
        if (r < 4) v = *(const f32x4*)(cp + (size_t)r * D + c4); else if (r < NCR) v = *(const f32x4*)(cs + (size_t)(r - 4) * D + c4);
        u32x2 o; o.x = cvt_pk_bf16(siluf_(v[0]), siluf_(v[1])); o.y = cvt_pk_bf16(siluf_(v[2]), siluf_(v[3]));
        *(u32x2*)(SC + (size_t)r * D + c4) = o;
    }
    LAS float* scr = (LAS float*)(lds + wave * 8448);
    const int gw = bid * 8 + wave, NGW = G * 8;
    constexpr int I_IN = 32 * 256, I_OUT = 32 * 64;
    for (int it = gw; it < 2 * I_IN + 2 * I_OUT; it += NGW) {
        if (it < 2 * I_IN) { const int l = it / I_IN, r = it % I_IN;
            transpose_item(a.in[10] + (size_t)l * D * DIN, DIN, 256, (bf16_t*)(a.ws + WS_WIN) + (size_t)l * NB * D, D, r, true, scr, lane); }
        else { const int j = it - 2 * I_IN, l = j / I_OUT, r = j % I_OUT;
            transpose_item(a.in[17] + (size_t)l * D * D, D, 64, (bf16_t*)(a.ws + WS_WOUT) + (size_t)l * D * D, D, r, false, scr, lane); }
    }
}

__device__ __forceinline__ void phase_ada(const Args& a, LAS unsigned char* lds, int tid, int lane, int wave, int G, int bid) {
    const bf16_t* SC = (const bf16_t*)(a.ws + WS_SC);
    float* MOD = (float*)(a.ws + WS_MOD);
    LAS float* red = (LAS float*)lds;
    const int r = lane & 31, hh = lane >> 5;
    for (int item = bid; item < 384; item += G) {
        const int l = item / 192, n0 = (item % 192) * 32;
        const float* W = a.in[8] + (size_t)l * D * NMOD;
        const int kbase = wave * 256;
        f32x16 acc[5];
#pragma unroll
        for (int i = 0; i < 5; ++i) acc[i] = zero16();
#pragma unroll 2
        for (int ks = 0; ks < 16; ++ks) {
            const int k0 = kbase + ks * 16;
            const float* wp = W + (size_t)(k0 + 8 * hh) * NMOD + n0 + r;
            float wv[8];
#pragma unroll
            for (int j = 0; j < 8; ++j) wv[j] = wp[(size_t)j * NMOD];
            union { u32x4 u; bf16x8 v; } bfr;
            bfr.u.x = cvt_pk_bf16(wv[0], wv[1]); bfr.u.y = cvt_pk_bf16(wv[2], wv[3]); bfr.u.z = cvt_pk_bf16(wv[4], wv[5]); bfr.u.w = cvt_pk_bf16(wv[6], wv[7]);
#pragma unroll
            for (int rb = 0; rb < 5; ++rb) { const bf16x8 af = *(const bf16x8*)(SC + (size_t)(rb * 32 + r) * D + k0 + 8 * hh); acc[rb] = mma32(af, bfr.v, acc[rb]); }
        }
#pragma unroll
        for (int rb = 0; rb < 5; ++rb) {
#pragma unroll
            for (int reg = 0; reg < 16; ++reg) red[wave * 1024 + reg * 64 + lane] = acc[rb][reg];
            __syncthreads();
#pragma unroll
            for (int e2 = 0; e2 < 2; ++e2) { const int e = tid + e2 * 512; float s = 0.f;
#pragma unroll
                for (int w = 0; w < 8; ++w) s += red[w * 1024 + e];
                const int reg = e >> 6, ln = e & 63; const int row = rb * 32 + rowof(reg, ln >> 5), col = n0 + (ln & 31);
                if (row < NCR) MOD[((size_t)l * NCR + row) * NMOD + col] = s + a.in[9][(size_t)l * NMOD + col]; }
            __syncthreads();
        }
    }
}

__device__ __forceinline__ void phase_norm(const Args& a, int l, LAS unsigned char* lds, int tid, int lane, int wave, int G, int bid) {
    LAS float* Wg = (LAS float*)lds;
    const float* win = a.in[10] + (size_t)l * D * DIN;
    for (int k = tid; k < D; k += 512) { const f32x4 w0 = *(const f32x4*)(win + (size_t)k * DIN + 5120), w1 = *(const f32x4*)(win + (size_t)k * DIN + 5124);
        Wg[0 * D + k] = w0[0]; Wg[1 * D + k] = w0[1]; Wg[2 * D + k] = w0[2]; Wg[3 * D + k] = w0[3];
        Wg[4 * D + k] = w1[0]; Wg[5 * D + k] = w1[1]; Wg[6 * D + k] = w1[2]; Wg[7 * D + k] = w1[3]; }
    __syncthreads();
    const float* xp = l == 0 ? a.in[0] : (const float*)(a.ws + WS_X1);
    const float* xs = l == 0 ? a.in[1] : (const float*)(a.ws + WS_X1) + (size_t)MP * D;
    const float* gn = a.in[7] + (size_t)l * D;
    const float* MOD = (const float*)(a.ws + WS_MOD) + (size_t)l * NCR * NMOD;
    bf16_t* HN = (bf16_t*)(a.ws + WS_HN);
    float* IG = (float*)(a.ws + WS_IG); float* LF = (float*)(a.ws + WS_LF);
    for (int r = bid * 8 + wave; r < MT; r += G * 8) {
        const float* xr = (r < MP ? xp + (size_t)r * D : xs + (size_t)(r - MP) * D) + lane * 4;
        const int mrow = r < MP ? (r >> 11) : 4 + (r - MP);
        const float* mp = MOD + (size_t)mrow * NMOD + lane * 4;
        f32x4 v[8]; float ss = 0.f;
#pragma unroll
        for (int i = 0; i < 8; ++i) { v[i] = *(const f32x4*)(xr + 256 * i); ss += (v[i][0] * v[i][0] + v[i][1] * v[i][1]) + (v[i][2] * v[i][2] + v[i][3] * v[i][3]); }
        const float rstd = rsqrtf(wave_sum(ss) * (1.0f / D) + EPS);
        float gd[8];
#pragma unroll
        for (int j = 0; j < 8; ++j) gd[j] = 0.f;
#pragma unroll
        for (int i = 0; i < 8; ++i) {
            const f32x4 g = *(const f32x4*)(gn + lane * 4 + 256 * i), sh = *(const f32x4*)(mp + 256 * i), sc = *(const f32x4*)(mp + 2048 + 256 * i);
            const f32x4 hv = v[i] * rstd * g * (sc + 1.0f) + sh;
            u32x2 o; o.x = cvt_pk_bf16(hv[0], hv[1]); o.y = cvt_pk_bf16(hv[2], hv[3]);
            *(u32x2*)(HN + (size_t)r * D + lane * 4 + 256 * i) = o;
#pragma unroll
            for (int j = 0; j < 8; ++j) { const f32x4 w = *(const LAS f32x4*)(Wg + j * D + lane * 4 + 256 * i); gd[j] += (hv[0] * w[0] + hv[1] * w[1]) + (hv[2] * w[2] + hv[3] * w[3]); }
        }
#pragma unroll
        for (int j = 0; j < 8; ++j) gd[j] = wave_sum(gd[j]);
        if (lane < 4) {
            const float gi = lane == 0 ? gd[0] : lane == 1 ? gd[1] : lane == 2 ? gd[2] : gd[3];
            const float gf = lane == 0 ? gd[4] : lane == 1 ? gd[5] : lane == 2 ? gd[6] : gd[7];
            IG[r * 4 + lane] = gi + a.in[11][l * 4 + lane];
            const float f = gf + a.in[12][l * 4 + lane];
            LF[r * 4 + lane] = fminf(f, 0.f) - log1pf(expf(-fabsf(f)));
        }
    }
    __syncthreads();
}

__device__ __forceinline__ void chunk_scan(const float* IG, const float* LF, int r0, int h, int lane, float& b0, float& b1, float& e0, float& e1, float& cm0, float& cm1) {
    const float lf0 = LF[(r0 + 2 * lane) * 4 + h], lf1 = LF[(r0 + 2 * lane + 1) * 4 + h];
    const float ig0 = IG[(r0 + 2 * lane) * 4 + h], ig1 = IG[(r0 + 2 * lane + 1) * 4 + h];
    float s = lf0 + lf1;
#pragma unroll
    for (int o = 1; o < 64; o <<= 1) { const float t = __shfl_up(s, o); if (lane >= o) s += t; }
    b1 = s; b0 = s - lf1;
    e0 = ig0 - b0; e1 = ig1 - b1;
    float mx = fmaxf(e0, e1);
#pragma unroll
    for (int o = 1; o < 64; o <<= 1) { const float t = __shfl_up(mx, o); if (lane >= o) mx = fmaxf(mx, t); }
    cm1 = mx;
    const float prev = __shfl_up(mx, 1);
    cm0 = lane > 0 ? fmaxf(prev, e0) : e0;
}

__device__ __forceinline__ void scan_item(const Args& a, int l, int item, LAS unsigned char* lds, int tid, int lane, int wave) {
    const int bh = item >> 3, vt = (item >> 2) & 1, dt = item & 3, b = bh >> 2, h = bh & 3;
    LAS unsigned char* Vt = lds;
    LAS unsigned char* Kt = lds + 34816;
    LAS float* E = (LAS float*)(lds + 53248);
    LAS float* Gs = E + 2048;
    LAS float* Bc = Gs + 2048; LAS float* CMX = Bc + 16; LAS float* MC = CMX + 16; LAS float* DEC = MC + 32;
    const float* IG = (const float*)(a.ws + WS_IG); const float* LF = (const float*)(a.ws + WS_LF);
    const bf16_t* P = (const bf16_t*)(a.ws + WS_P);
    bf16_t* CST = (bf16_t*)(a.ws + WS_CST); float* NST = (float*)(a.ws + WS_NST); float* MST = (float*)(a.ws + WS_MST);
#pragma unroll
    for (int j = 0; j < 2; ++j) { const int cc = 2 * wave + j; float b0, b1, e0, e1, cm0, cm1;
        chunk_scan(IG, LF, b * 2048 + cc * 128, h, lane, b0, b1, e0, e1, cm0, cm1);
        E[cc * 128 + 2 * lane] = e0; E[cc * 128 + 2 * lane + 1] = e1;
        if (lane == 63) { Bc[cc] = b1; CMX[cc] = cm1; } }
    __syncthreads();
    if (tid == 0) { float m = 0.f;
        for (int cc = 0; cc < 16; ++cc) { MC[cc] = m; const float mn = Bc[cc] + fmaxf(m, CMX[cc]); DEC[cc] = __expf(Bc[cc] + m - mn); m = mn; }
        MC[16] = m; }
    __syncthreads();
    for (int t = tid; t < 2048; t += 512) { const int cc = t >> 7; Gs[t] = __expf(Bc[cc] + E[t] - MC[cc + 1]) * 0.0625f; }
    if (vt == 0 && dt == 0) { if (tid < 16) MST[bh * 16 + tid] = MC[tid]; if (tid == 0) a.out[OMP + l * 16 + bh] = MC[16]; }
    f32x16 acc = zero16(), nblk = zero16();
    const int vb = wave >> 1, db = wave & 1, r = lane & 31, hh = lane >> 5;
    const bool nwave = (vt == 0 && vb == 0);
    u32x4 vraw[4], kraw[2];
    { const int r0 = b * 2048;
#pragma unroll
      for (int i2 = 0; i2 < 4; ++i2) { const int i = tid + i2 * 512, s_ = i >> 4, ch = i & 15; vraw[i2] = *(const u32x4*)(P + (size_t)(r0 + s_) * NB + 2048 + h * 256 + vt * 128 + ch * 8); }
#pragma unroll
      for (int i2 = 0; i2 < 2; ++i2) { const int i = tid + i2 * 512, s_ = i >> 3, ch = i & 7; kraw[i2] = *(const u32x4*)(P + (size_t)(r0 + s_) * NB + 1024 + h * 256 + dt * 64 + ch * 8); } }
    for (int c = 0; c < 16; ++c) {
        { bf16_t* cp_ = CST + ((size_t)(bh * 16 + c) * 256 + vt * 128 + vb * 32 + r) * 256 + dt * 64 + db * 32 + 4 * hh;
#pragma unroll
          for (int q4 = 0; q4 < 4; ++q4) { u32x2 o; o.x = cvt_pk_bf16(acc[4 * q4 + 0], acc[4 * q4 + 1]); o.y = cvt_pk_bf16(acc[4 * q4 + 2], acc[4 * q4 + 3]); *(u32x2*)(cp_ + 8 * q4) = o; } }
        if (nwave && r == 0) {
#pragma unroll
            for (int reg = 0; reg < 16; ++reg) NST[(bh * 16 + c) * 256 + dt * 64 + db * 32 + rowof(reg, hh)] = nblk[reg]; }
        __syncthreads();
#pragma unroll
        for (int i2 = 0; i2 < 4; ++i2) { const int i = tid + i2 * 512, s_ = i >> 4, ch = i & 15;
            const u32x4 raw = vraw[i2]; const float g = Gs[c * 128 + s_];
            u32x4 o; o.x = cvt_pk_bf16(bflo(raw.x) * g, bfhi(raw.x) * g); o.y = cvt_pk_bf16(bflo(raw.y) * g, bfhi(raw.y) * g);
            o.z = cvt_pk_bf16(bflo(raw.z) * g, bfhi(raw.z) * g); o.w = cvt_pk_bf16(bflo(raw.w) * g, bfhi(raw.w) * g);
            *(LAS u32x4*)(Vt + s_ * 272 + ch * 16) = o; }
        if (tid < 128) { u32x4 o; o.x = cvt_pk_bf16(Gs[c * 128 + tid], 0.f); o.y = 0u; o.z = 0u; o.w = 0u; *(LAS u32x4*)(Vt + tid * 272 + 256) = o; }
#pragma unroll
        for (int i2 = 0; i2 < 2; ++i2) { const int i = tid + i2 * 512, s_ = i >> 3, ch = i & 7; *(LAS u32x4*)(Kt + s_ * 144 + ch * 16) = kraw[i2]; }
        if (c < 15) { const int r0 = b * 2048 + (c + 1) * 128;
#pragma unroll
            for (int i2 = 0; i2 < 4; ++i2) { const int i = tid + i2 * 512, s_ = i >> 4, ch = i & 15; vraw[i2] = *(const u32x4*)(P + (size_t)(r0 + s_) * NB + 2048 + h * 256 + vt * 128 + ch * 8); }
#pragma unroll
            for (int i2 = 0; i2 < 2; ++i2) { const int i = tid + i2 * 512, s_ = i >> 3, ch = i & 7; kraw[i2] = *(const u32x4*)(P + (size_t)(r0 + s_) * NB + 1024 + h * 256 + dt * 64 + ch * 8); } }
        __syncthreads();
        const float dec = DEC[c];
#pragma unroll
        for (int reg = 0; reg < 16; ++reg) { acc[reg] *= dec; nblk[reg] *= dec; }
        if (nwave) {
#pragma unroll
            for (int ks = 0; ks < 8; ++ks) { const bf16x8 vf = frag_tr(Vt, 272, ks * 16, vb * 32, lane); const bf16x8 kf = frag_tr(Kt, 144, ks * 16, db * 32, lane); const bf16x8 gf = frag_tr(Vt, 272, ks * 16, 128, lane);
                acc = mma32(kf, vf, acc); nblk = mma32(kf, gf, nblk); }
        } else {
#pragma unroll
            for (int ks = 0; ks < 8; ++ks) { const bf16x8 vf = frag_tr(Vt, 272, ks * 16, vb * 32, lane); const bf16x8 kf = frag_tr(Kt, 144, ks * 16, db * 32, lane); acc = mma32(kf, vf, acc); }
        }
    }
    { float* op_ = a.out + OCP + ((size_t)(l * 16 + bh) * 256 + vt * 128 + vb * 32 + r) * 256 + dt * 64 + db * 32 + 4 * hh;
#pragma unroll
      for (int q4 = 0; q4 < 4; ++q4) *(f32x4*)(op_ + 8 * q4) = (f32x4){acc[4 * q4 + 0], acc[4 * q4 + 1], acc[4 * q4 + 2], acc[4 * q4 + 3]}; }
    if (nwave && r == 0) {
#pragma unroll
        for (int reg = 0; reg < 16; ++reg) a.out[ONP + (l * 16 + bh) * 256 + dt * 64 + db * 32 + rowof(reg, hh)] = nblk[reg]; }
    __syncthreads();
}

__device__ __forceinline__ void mix_item(const Args& a, int l, int item, LAS unsigned char* lds, int tid, int lane, int wave) {
    const int b = item >> 6, c = (item >> 2) & 15, g = item & 3, r0 = b * 2048 + c * 128;
    LAS unsigned char* VN = lds;
    LAS unsigned char* WW = lds + 67584;
    const bf16_t* P = (const bf16_t*)(a.ws + WS_P);
    bf16_t* ACT = (bf16_t*)(a.ws + WS_ACT);
    const float* ws_ = a.in[15] + (size_t)(l * 4 + g) * 128 * 128;
#pragma unroll
    for (int i2 = 0; i2 < 8; ++i2) { const int i = tid + i2 * 512, t = i >> 5, s4 = (i & 31) * 4;
        f32x4 w = *(const f32x4*)(ws_ + t * 128 + s4);
        if (s4 + 0 > t) w[0] = 0.f; if (s4 + 1 > t) w[1] = 0.f; if (s4 + 2 > t) w[2] = 0.f; if (s4 + 3 > t) w[3] = 0.f;
        u32x2 o; o.x = cvt_pk_bf16(w[0], w[1]); o.y = cvt_pk_bf16(w[2], w[3]);
        *(LAS u32x2*)(WW + t * 272 + s4 * 2) = o; }
    const f32x4 gc = *(const f32x4*)(a.in[14] + l * 1024 + g * 256 + lane * 4);
    for (int i = 0; i < 16; ++i) { const int s = wave * 16 + i;
        const u32x2 raw = *(const u32x2*)(P + (size_t)(r0 + s) * NB + 6144 + g * 256 + lane * 4);
        float x0 = geluf_(bflo(raw.x)), x1 = geluf_(bfhi(raw.x)), x2 = geluf_(bflo(raw.y)), x3 = geluf_(bfhi(raw.y));
        const float mean = wave_sum((x0 + x1) + (x2 + x3)) * (1.0f / 256.0f);
        x0 -= mean; x1 -= mean; x2 -= mean; x3 -= mean;
        const float rstd = rsqrtf(wave_sum((x0 * x0 + x1 * x1) + (x2 * x2 + x3 * x3)) * (1.0f / 256.0f) + EPS);
        u32x2 o; o.x = cvt_pk_bf16(x0 * rstd * gc[0], x1 * rstd * gc[1]); o.y = cvt_pk_bf16(x2 * rstd * gc[2], x3 * rstd * gc[3]);
        *(LAS u32x2*)(VN + s * 528 + lane * 8) = o; }
    __syncthreads();
    const int tb = wave >> 1, cb0 = (wave & 1) * 4, r = lane & 31, hh = lane >> 5;
    f32x16 acc[4];
#pragma unroll
    for (int j = 0; j < 4; ++j) acc[j] = zero16();
    for (int ks = 0; ks < 2 * (tb + 1); ++ks) { const bf16x8 wf = frag_row(WW, 272, tb * 32, ks * 16, lane);
#pragma unroll
        for (int j = 0; j < 4; ++j) { const bf16x8 vf = frag_tr(VN, 528, ks * 16, (cb0 + j) * 32, lane); acc[j] = mma32(vf, wf, acc[j]); } }
    { const int t = tb * 32 + r; const float bias = a.in[16][(l * 4 + g) * 128 + t];
      const bf16_t* prow = P + (size_t)(r0 + t) * NB + g * 256 + 4 * hh; bf16_t* arow = ACT + (size_t)(r0 + t) * D + 1024 + g * 256 + 4 * hh;
#pragma unroll
      for (int j = 0; j < 4; ++j)
#pragma unroll
        for (int q4 = 0; q4 < 4; ++q4) { const int chb = (cb0 + j) * 32 + 8 * q4;
            const u32x2 ur = *(const u32x2*)(prow + 5120 + chb), zr = *(const u32x2*)(prow + 7168 + chb);
            const float o0 = geluf_(bflo(ur.x)) * (acc[j][4 * q4 + 0] + bias) * siluf_(bflo(zr.x)), o1 = geluf_(bfhi(ur.x)) * (acc[j][4 * q4 + 1] + bias) * siluf_(bfhi(zr.x));
            const float o2 = geluf_(bflo(ur.y)) * (acc[j][4 * q4 + 2] + bias) * siluf_(bflo(zr.y)), o3 = geluf_(bfhi(ur.y)) * (acc[j][4 * q4 + 3] + bias) * siluf_(bfhi(zr.y));
            u32x2 o; o.x = cvt_pk_bf16(o0, o1); o.y = cvt_pk_bf16(o2, o3); *(u32x2*)(arow + chb) = o; } }
    __syncthreads();
}

__device__ __forceinline__ void sample_item(const Args& a, int l, int item, LAS unsigned char* lds, int tid, int lane, int wave) {
    const int rr = item >> 2, h = item & 3, R = MP + rr;
    LAS float* q = (LAS float*)lds; LAS float* k = q + 256; LAS float* vv = q + 512; LAS float* n0 = q + 768; LAS float* CQ = q + 1024; LAS float* HH = q + 1280; LAS float* RED = q + 1536;
    const bf16_t* P = (const bf16_t*)(a.ws + WS_P);
    bf16_t* ACT = (bf16_t*)(a.ws + WS_ACT);
    const bf16_t* prow = P + (size_t)R * NB;
    const size_t sidx = (size_t)(l * 128 + rr) * 4 + h;
    if (tid < 256) { q[tid] = bf2f(prow[h * 256 + tid]); k[tid] = bf2f(prow[1024 + h * 256 + tid]) * 0.0625f; vv[tid] = bf2f(prow[2048 + h * 256 + tid]); n0[tid] = a.in[3][sidx * 256 + tid]; }
    __syncthreads();
    const float ig = ((const float*)(a.ws + WS_IG))[R * 4 + h], lf = ((const float*)(a.ws + WS_LF))[R * 4 + h], m0 = a.in[4][sidx];
    const float a_ = lf + m0, mt = fmaxf(a_, ig), wintra = __expf(ig - mt), winter = __expf(a_ - mt);
    const f32x4 q4 = *(const LAS f32x4*)(q + lane * 4), k4 = *(const LAS f32x4*)(k + lane * 4), n4 = *(const LAS f32x4*)(n0 + lane * 4);
    const float qk = wave_sum((q4[0] * k4[0] + q4[1] * k4[1]) + (q4[2] * k4[2] + q4[3] * k4[3]));
    const float nq = wave_sum((q4[0] * n4[0] + q4[1] * n4[1]) + (q4[2] * n4[2] + q4[3] * n4[3]));
    const float s = qk * wintra, den = winter * nq + s, inv = 1.0f / fmaxf(fabsf(den), __expf(-mt));
    const float* C0 = a.in[2] + sidx * 65536; float* C1 = a.out + OCS + sidx * 65536;
#pragma unroll 1
    for (int i0 = 0; i0 < 32; i0 += 16) {
        f32x4 c4[16];
#pragma unroll
        for (int i = 0; i < 16; ++i) c4[i] = __builtin_nontemporal_load((const f32x4*)(C0 + (size_t)(wave * 32 + i0 + i) * 256 + lane * 4));
#pragma unroll
        for (int i = 0; i < 16; ++i) { const int vrow = wave * 32 + i0 + i;
            float dot = (c4[i][0] * q4[0] + c4[i][1] * q4[1]) + (c4[i][2] * q4[2] + c4[i][3] * q4[3]);
            const float gv = wintra * vv[vrow];
            const f32x4 cn = c4[i] * winter + k4 * gv;
            __builtin_nontemporal_store(cn, (f32x4*)(C1 + (size_t)vrow * 256 + lane * 4));
            dot = wave_sum(dot); if (lane == 0) CQ[vrow] = dot; } }
    __syncthreads();
    float hv = 0.f, xg = 0.f;
    if (tid < 256) { const float num = winter * CQ[tid] + s * vv[tid]; hv = num * inv * sigmoidf_(bf2f(prow[3072 + h * 256 + tid])); HH[tid] = hv;
        a.out[ONS + sidx * 256 + tid] = winter * n0[tid] + wintra * k[tid];
        const float p = wave_sum(hv * hv); if (lane == 0) RED[wave] = p; }
    else { xg = geluf_(bf2f(prow[6144 + h * 256 + (tid - 256)])); const float p = wave_sum(xg); if (lane == 0) RED[wave] = p; }
    if (tid == 0) a.out[OMS + sidx] = mt;
    __syncthreads();
    if (tid < 256) { const float rstd = rsqrtf(((RED[0] + RED[1]) + (RED[2] + RED[3])) * (1.0f / 256.0f) + EPS);
        ACT[(size_t)R * D + h * 256 + tid] = f2bf(hv * rstd * a.in[13][l * 1024 + h * 256 + tid] * siluf_(bf2f(prow[4096 + h * 256 + tid]))); }
    else { const float mean = ((RED[4] + RED[5]) + (RED[6] + RED[7])) * (1.0f / 256.0f); xg -= mean; const float p = wave_sum(xg * xg); if (lane == 0) RED[4 + wave] = p; }
    __syncthreads();
    if (tid >= 256) { const int ch = tid - 256; const float rstd = rsqrtf(((RED[8] + RED[9]) + (RED[10] + RED[11])) * (1.0f / 256.0f) + EPS);
        const float vn = xg * rstd * a.in[14][l * 1024 + h * 256 + ch];
        a.out[OVS + (size_t)(l * 128 + rr) * 1024 + h * 256 + ch] = vn;
        const float w00 = a.in[15][(size_t)(l * 4 + h) * 16384], b0 = a.in[16][(l * 4 + h) * 128];
        ACT[(size_t)R * D + 1024 + h * 256 + ch] = f2bf(geluf_(bf2f(prow[5120 + h * 256 + ch])) * (w00 * vn + b0) * siluf_(bf2f(prow[7168 + h * 256 + ch]))); }
    __syncthreads();
}

__device__ __forceinline__ void mlstm_out_item(const Args& a, int l, int item, LAS unsigned char* lds, int tid, int lane, int wave) {
    const int bh = item >> 4, c = item & 15, b = bh >> 2, h = bh & 3, r0 = b * 2048 + c * 128;
    LAS unsigned char* KC = lds;
    LAS unsigned char* SS = lds + 67584;
    LAS unsigned char* VV = lds + 67584 + 34816;
    LAS float* SM = (LAS float*)(lds + 137216);
    LAS float* E = SM; LAS float* MX = SM + 128; LAS float* BT = SM + 256; LAS float* NQ = SM + 384; LAS float* INV = SM + 512; LAS float* WI = SM + 640; LAS float* SSQ = SM + 768; LAS float* NV = SM + 1024;
    const bf16_t* P = (const bf16_t*)(a.ws + WS_P);
    bf16_t* ACT = (bf16_t*)(a.ws + WS_ACT);
    const bf16_t* CST = (const bf16_t*)(a.ws + WS_CST) + (size_t)(bh * 16 + c) * 65536;
    const int tb = wave >> 1, sub = wave & 1, r = lane & 31, hh = lane >> 5;
    const float m_c = ((const float*)(a.ws + WS_MST))[bh * 16 + c];
    if (wave == 0) { float b0, b1, e0, e1, cm0, cm1;
        chunk_scan((const float*)(a.ws + WS_IG), (const float*)(a.ws + WS_LF), r0, h, lane, b0, b1, e0, e1, cm0, cm1);
        E[2 * lane] = e0; E[2 * lane + 1] = e1; MX[2 * lane] = fmaxf(m_c, cm0); MX[2 * lane + 1] = fmaxf(m_c, cm1); BT[2 * lane] = b0; BT[2 * lane + 1] = b1; }
    if (tid < 256) NV[tid] = ((const float*)(a.ws + WS_NST))[(bh * 16 + c) * 256 + tid];
#pragma unroll
    for (int i2 = 0; i2 < 8; ++i2) { const int i = tid + i2 * 512, s = i >> 5, ch = i & 31;
        *(LAS u32x4*)(KC + s * 528 + ch * 16) = *(const u32x4*)(P + (size_t)(r0 + s) * NB + 1024 + h * 256 + ch * 8); }
    bf16x8 qf[16];
    { const bf16_t* qrow = P + (size_t)(r0 + tb * 32 + r) * NB + h * 256 + 8 * hh;
#pragma unroll
      for (int ks = 0; ks < 16; ++ks) qf[ks] = *(const bf16x8*)(qrow + ks * 16); }
    __syncthreads();
    if (sub == 0) { float p = 0.f;
#pragma unroll
        for (int ks = 0; ks < 16; ++ks)
#pragma unroll
            for (int j = 0; j < 8; ++j) p += bf2f((bf16_t)qf[ks][j]) * NV[16 * ks + 8 * hh + j];
        p += __shfl_xor(p, 32); if (hh == 0) NQ[tb * 32 + r] = p; }
    const int t = tb * 32 + r;
#pragma unroll
    for (int jb = 0; jb < 2; ++jb) { const int sb = 2 * sub + jb;
        if (sb <= tb) { f32x16 acc = zero16();
#pragma unroll
            for (int ks = 0; ks < 16; ++ks) { const bf16x8 kf = frag_row(KC, 528, sb * 32, ks * 16, lane); acc = mma32(kf, qf[ks], acc); }
            const float mxt = MX[t];
#pragma unroll
            for (int q4 = 0; q4 < 4; ++q4) { const int s0 = sb * 32 + 8 * q4 + 4 * hh; const f32x4 e4 = *(const LAS f32x4*)(E + s0);
                const float w0 = (s0 + 0 <= t) ? __expf(e4[0] - mxt) * 0.0625f : 0.f, w1 = (s0 + 1 <= t) ? __expf(e4[1] - mxt) * 0.0625f : 0.f;
                const float w2 = (s0 + 2 <= t) ? __expf(e4[2] - mxt) * 0.0625f : 0.f, w3 = (s0 + 3 <= t) ? __expf(e4[3] - mxt) * 0.0625f : 0.f;
                u32x2 o; o.x = cvt_pk_bf16(acc[4 * q4 + 0] * w0, acc[4 * q4 + 1] * w1); o.y = cvt_pk_bf16(acc[4 * q4 + 2] * w2, acc[4 * q4 + 3] * w3);
                *(LAS u32x2*)(SS + t * 272 + s0 * 2) = o; } } }
    __syncthreads();
    f32x16 hval[2][2];
#pragma unroll
    for (int hv = 0; hv < 2; ++hv) {
        if (hv) __syncthreads();
#pragma unroll
        for (int i2 = 0; i2 < 4; ++i2) { const int i = tid + i2 * 512, s = i >> 4, ch = i & 15;
            *(LAS u32x4*)(VV + s * 272 + ch * 16) = *(const u32x4*)(P + (size_t)(r0 + s) * NB + 2048 + h * 256 + hv * 128 + ch * 8); }
#pragma unroll
        for (int i2 = 0; i2 < 8; ++i2) { const int i = tid + i2 * 512, v = i >> 5, ch = i & 31;
            *(LAS u32x4*)(KC + v * 528 + ch * 16) = *(const u32x4*)(CST + (size_t)(hv * 128 + v) * 256 + ch * 8); }
        if (hv == 0) { const int tt = tid >> 2, part = tid & 3; float sum = 0.f;
            if (part <= (tt >> 5)) {
#pragma unroll
                for (int j = 0; j < 4; ++j) { const u32x4 w = *(const LAS u32x4*)(SS + tt * 272 + part * 64 + j * 16);
                    sum += (bflo(w.x) + bfhi(w.x)) + (bflo(w.y) + bfhi(w.y)) + (bflo(w.z) + bfhi(w.z)) + (bflo(w.w) + bfhi(w.w)); } }
            sum += __shfl_xor(sum, 1); sum += __shfl_xor(sum, 2);
            if (part == 0) { const float wi = __expf(m_c - MX[tt]); const float den = wi * NQ[tt] + sum; const float mt = BT[tt] + MX[tt];
                INV[tt] = 1.0f / fmaxf(fabsf(den), __expf(-mt)); WI[tt] = wi; } }
        __syncthreads();
        const float wi = WI[t], inv = INV[t];
#pragma unroll
        for (int jb = 0; jb < 2; ++jb) { const int vb = 2 * sub + jb; f32x16 acc = zero16();
#pragma unroll
            for (int ks = 0; ks < 16; ++ks) { const bf16x8 cf = frag_row(KC, 528, vb * 32, ks * 16, lane); acc = mma32(cf, qf[ks], acc); }
#pragma unroll
            for (int reg = 0; reg < 16; ++reg) acc[reg] *= wi;
            for (int ks = 0; ks < 2 * (tb + 1); ++ks) { const bf16x8 sf = frag_row(SS, 272, tb * 32, ks * 16, lane); const bf16x8 vf = frag_tr(VV, 272, ks * 16, vb * 32, lane); acc = mma32(vf, sf, acc); }
            const bf16_t* orow = P + (size_t)(r0 + t) * NB + 3072 + h * 256 + hv * 128 + vb * 32 + 4 * hh;
#pragma unroll
            for (int q4 = 0; q4 < 4; ++q4) { const u32x2 raw = *(const u32x2*)(orow + 8 * q4);
                acc[4 * q4 + 0] *= inv * sigmoidf_(bflo(raw.x)); acc[4 * q4 + 1] *= inv * sigmoidf_(bfhi(raw.x));
                acc[4 * q4 + 2] *= inv * sigmoidf_(bflo(raw.y)); acc[4 * q4 + 3] *= inv * sigmoidf_(bfhi(raw.y)); }
            hval[hv][jb] = acc; }
    }
    { float s2 = 0.f;
#pragma unroll
      for (int reg = 0; reg < 16; ++reg) s2 += (hval[0][0][reg] * hval[0][0][reg] + hval[0][1][reg] * hval[0][1][reg]) + (hval[1][0][reg] * hval[1][0][reg] + hval[1][1][reg] * hval[1][1][reg]);
      s2 += __shfl_xor(s2, 32);
      if (hh == 0) SSQ[sub * 128 + t] = s2; }
    __syncthreads();
    { const float rstd = rsqrtf((SSQ[t] + SSQ[128 + t]) * (1.0f / 256.0f) + EPS);
      const float* gm = a.in[13] + l * 1024 + h * 256 + 4 * hh;
      const bf16_t* zrow = P + (size_t)(r0 + t) * NB + 4096 + h * 256 + 4 * hh; bf16_t* arow = ACT + (size_t)(r0 + t) * D + h * 256 + 4 * hh;
#pragma unroll
      for (int hv = 0; hv < 2; ++hv)
#pragma unroll
        for (int jb = 0; jb < 2; ++jb)
#pragma unroll
            for (int q4 = 0; q4 < 4; ++q4) { const int cb = hv * 128 + (2 * sub + jb) * 32 + 8 * q4;
                const u32x2 zr = *(const u32x2*)(zrow + cb); const f32x4 g4 = *(const f32x4*)(gm + cb);
                u32x2 o; o.x = cvt_pk_bf16(hval[hv][jb][4 * q4 + 0] * rstd * g4[0] * siluf_(bflo(zr.x)), hval[hv][jb][4 * q4 + 1] * rstd * g4[1] * siluf_(bfhi(zr.x)));
                o.y = cvt_pk_bf16(hval[hv][jb][4 * q4 + 2] * rstd * g4[2] * siluf_(bflo(zr.y)), hval[hv][jb][4 * q4 + 3] * rstd * g4[3] * siluf_(bfhi(zr.y)));
                *(u32x2*)(arow + cb) = o; } }
    __syncthreads();
}

__device__ __forceinline__ void phase_final(const Args& a, int tid, int lane, int wave, int G, int bid) {
    const float* gf = a.in[18];
    for (int r = bid * 8 + wave; r < MT; r += G * 8) {
        float* xr = a.out + OY + (size_t)r * D + lane * 4;
        f32x4 v[8]; float ss = 0.f;
#pragma unroll
        for (int i = 0; i < 8; ++i) { v[i] = *(const f32x4*)(xr + 256 * i); ss += (v[i][0] * v[i][0] + v[i][1] * v[i][1]) + (v[i][2] * v[i][2] + v[i][3] * v[i][3]); }
        const float rstd = rsqrtf(wave_sum(ss) * (1.0f / D) + EPS);
#pragma unroll
        for (int i = 0; i < 8; ++i) { const f32x4 g = *(const f32x4*)(gf + lane * 4 + 256 * i); *(f32x4*)(xr + 256 * i) = v[i] * rstd * g; }
    }
}

__global__ void __launch_bounds__(512, 2) fwd_megakernel(Args a) {
    extern __shared__ __attribute__((aligned(16))) unsigned char lds_raw[];
    LAS unsigned char* lds = (LAS unsigned char*)lds_raw;
    cg::grid_group grid = cg::this_grid();
    const int G = gridDim.x, bid = blockIdx.x;
    const int lo = a.ph_lo, hi = a.ph_hi;
    if (hi > NPHASE) grid.sync();
    if (threadIdx.x < 4) ((LAS unsigned*)(lds + LDS_BYTES - 16))[threadIdx.x] = 0u;
    __syncthreads();
    const XcdBarrier xbar = xcd_barrier_post((unsigned*)a.ws, (volatile LAS unsigned*)(lds + LDS_BYTES - 16));
#define IN(k) (lo <= (k) && (k) < hi)
#define SEAM(k) do { if (IN(k) && IN((k) + 1)) { xcd_barrier(xbar); if (PROBE == 20) xcd_barrier(xbar); } } while (0)
#define TIDS int tid = threadIdx.x; asm volatile("" : "+v"(tid)); const int lane = tid & 63, wave = __builtin_amdgcn_readfirstlane(tid >> 6);
#define REPEAT(n) for (int rep_ = 0; rep_ < ((PROBE == (n)) ? 2 : 1); ++rep_)
#define RSYNC(n) do { if (PROBE == (n) && rep_ == 0) xcd_barrier(xbar); } while (0)
    REPEAT(1) { if (IN(0)) { TIDS phase0(a, lds, tid, lane, wave, G, bid); } RSYNC(1); }
    SEAM(0);
    REPEAT(2) { if (IN(1)) { TIDS phase_ada(a, lds, tid, lane, wave, G, bid); } RSYNC(2); }
    SEAM(1);
#pragma unroll 1
    for (int l = 0; l < 2; ++l) {
        const int pb = 2 + 5 * l;
        REPEAT(3) { if (IN(pb)) { TIDS phase_norm(a, l, lds, tid, lane, wave, G, bid); } RSYNC(3); }
        SEAM(pb);
        REPEAT(4) { if (IN(pb + 1)) {
            pg8::Gemm g{(const bf16_t*)(a.ws + WS_HN), (const bf16_t*)(a.ws + WS_WIN) + (size_t)l * NB * D, MP, NB, D};
            pg8::StaticOrder S; S.init(MP, NB, G, bid);
            pg8::EpiP E{(bf16_t*)(a.ws + WS_P), NB};
            pg8::gemm_phase<pg8::EpiP, pg8::StaticOrder>(lds, g, S, E);
#pragma unroll 1
            for (int item = bid; item < 256; item += G) { TIDS skinny_item<0>(a, l, item * 32, (const bf16_t*)(a.ws + WS_HN) + (size_t)MP * D, (const bf16_t*)(a.ws + WS_WIN) + (size_t)l * NB * D, lds, tid, lane, wave); }
        } RSYNC(4); }
        SEAM(pb + 1);
        REPEAT(5) { if (IN(pb + 2)) {
#pragma unroll 1
            for (int item = bid; item < 896; item += G) { TIDS
                if (item < 128) { scan_item(a, l, item, lds, tid, lane, wave); if (PROBE == 8) scan_item(a, l, item, lds, tid, lane, wave); }
                else if (item < 384) { mix_item(a, l, item - 128, lds, tid, lane, wave); if (PROBE == 9) mix_item(a, l, item - 128, lds, tid, lane, wave); }
                else { sample_item(a, l, item - 384, lds, tid, lane, wave); if (PROBE == 10) sample_item(a, l, item - 384, lds, tid, lane, wave); }
            }
        } RSYNC(5); }
        SEAM(pb + 2);
        REPEAT(6) { if (IN(pb + 3)) {
#pragma unroll 1
            for (int item = bid; item < 256; item += G) { TIDS mlstm_out_item(a, l, item, lds, tid, lane, wave); }
        } RSYNC(6); }
        SEAM(pb + 3);
        REPEAT(7) { if (IN(pb + 4)) {
            pg8::Gemm g{(const bf16_t*)(a.ws + WS_ACT), (const bf16_t*)(a.ws + WS_WOUT) + (size_t)l * D * D, MP, D, D};
            pg8::StaticOrder S; S.init(MP, D, G, bid);
            pg8::EpiRes E{l == 0 ? a.in[0] : (const float*)(a.ws + WS_X1), l == 0 ? a.in[1] : (const float*)(a.ws + WS_X1) + (size_t)MP * D,
                          l == 0 ? (float*)(a.ws + WS_X1) : a.out + OY, (const float*)(a.ws + WS_MOD) + (size_t)l * NCR * NMOD};
            pg8::gemm_phase<pg8::EpiRes, pg8::StaticOrder>(lds, g, S, E);
#pragma unroll 1
            for (int item = bid; item < 64; item += G) { TIDS skinny_item<1>(a, l, item * 32, (const bf16_t*)(a.ws + WS_ACT) + (size_t)MP * D, (const bf16_t*)(a.ws + WS_WOUT) + (size_t)l * D * D, lds, tid, lane, wave); }
        } RSYNC(7); }
        SEAM(pb + 4);
    }
    if (IN(12)) { TIDS phase_final(a, tid, lane, wave, G, bid); }
#undef TIDS
#undef IN
#undef SEAM
}

#ifndef N_LAUNCH_MODE
#define N_LAUNCH_MODE 1
#endif

extern "C" void kernel_launch(void* const* d_in, const int* in_sizes, int n_in, void* d_out, int out_size, void* d_ws, size_t ws_size, hipStream_t stream) {
    static int grid = 0;
    if (grid == 0) {
        int dev = 0, cus = 0, per_cu = 0;
        hipGetDevice(&dev);
        hipDeviceGetAttribute(&cus, hipDeviceAttributeMultiprocessorCount, dev);
        hipFuncSetAttribute((const void*)fwd_megakernel, hipFuncAttributeMaxDynamicSharedMemorySize, LDS_BYTES);
        hipOccupancyMaxActiveBlocksPerMultiprocessor(&per_cu, (const void*)fwd_megakernel, 512, LDS_BYTES);
        if (per_cu < 1) { fprintf(stderr, "occupancy query returned %d\n", per_cu); per_cu = 1; }
        grid = cus * per_cu;
        if (n_in != 19 || ws_size < WS_END) { fprintf(stderr, "unexpected n_in %d / ws %zu\n", n_in, ws_size); }
    }
    (void)hipMemsetAsync(d_ws, 0, 16384, stream);
    Args a{};
    for (int i = 0; i < 19; ++i) a.in[i] = (const float*)d_in[i];
    a.out = (float*)d_out; a.ws = (unsigned char*)d_ws;
#if N_LAUNCH_MODE == 1
    a.ph_lo = 0; a.ph_hi = NPHASE;
    void* args[] = {&a};
    hipError_t e = hipLaunchCooperativeKernel((const void*)fwd_megakernel, dim3(grid), dim3(512), args, LDS_BYTES, stream);
    if (e != hipSuccess) fprintf(stderr, "cooperative launch failed: %s (grid %d)\n", hipGetErrorString(e), grid);
#else
    for (int p = 0; p < NPHASE; ++p) {
        a.ph_lo = p; a.ph_hi = p + 1;
        void* args[] = {&a};
        hipError_t e = hipLaunchCooperativeKernel((const void*)fwd_megakernel, dim3(grid), dim3(512), args, LDS_BYTES, stream);
        if (e != hipSuccess) { fprintf(stderr, "launch %d failed: %s (grid %d)\n", p, hipGetErrorString(e), grid); break; }
    }
#endif
}
```

```cpp
#include <hip/hip_runtime.h>
#include <hip/hip_cooperative_groups.h>
#include <cstdio>
namespace cg = cooperative_groups;

#define LAS __attribute__((address_space(3)))
typedef unsigned short bf16_t;
typedef short bf16x8 __attribute__((ext_vector_type(8)));
typedef short s16x4 __attribute__((ext_vector_type(4)));
typedef float f32x4 __attribute__((ext_vector_type(4)));
typedef float f32x16 __attribute__((ext_vector_type(16)));
typedef unsigned u32x4 __attribute__((ext_vector_type(4)));
typedef unsigned u32x2 __attribute__((ext_vector_type(2)));

constexpr int D = 2048, MP = 8192, MS = 128, MT = 8320, MPAD = 8448;
constexpr int NB = 8192, DIN = 8200, NMOD = 6144, NCR = 132;
constexpr float EPS = 1e-6f;
constexpr size_t OY = 0, OCP = 17039360, ONP = 19136512, OMP = 19144704, OCS = 19144736, ONS = 86253600, OMS = 86515744, OVS = 86516768;
constexpr size_t MiB = 1u << 20;
constexpr size_t WS_WIN = 1 * MiB;
constexpr size_t WS_WOUT = 65 * MiB;
constexpr size_t WS_SC = 81 * MiB;
constexpr size_t WS_MOD = 82 * MiB;
constexpr size_t WS_HN = 90 * MiB;
constexpr size_t WS_P = 123 * MiB;
constexpr size_t WS_IG = 255 * MiB;
constexpr size_t WS_LF = 255 * MiB + 512 * 1024;
constexpr size_t WS_X1 = 256 * MiB;
constexpr size_t WS_ACT = 321 * MiB;
constexpr size_t WS_CST = 354 * MiB;
constexpr size_t WS_NST = 386 * MiB;
constexpr size_t WS_MST = 386 * MiB + 512 * 1024;
constexpr size_t WS_END = 387 * MiB;
constexpr int LDS_BYTES = 155648;
constexpr int NPHASE = 13;
#ifndef PROBE
#define PROBE 0
#endif

struct Args { const float* in[19]; float* out; unsigned char* ws; int ph_lo, ph_hi; };

__device__ __forceinline__ float bf2f(bf16_t b) { return __uint_as_float(((unsigned)b) << 16); }
__device__ __forceinline__ float bflo(unsigned w) { return __uint_as_float(w << 16); }
__device__ __forceinline__ float bfhi(unsigned w) { return __uint_as_float(w & 0xffff0000u); }
__device__ __forceinline__ unsigned cvt_pk_bf16(float lo, float hi) { unsigned r; asm volatile("v_cvt_pk_bf16_f32 %0, %1, %2" : "=v"(r) : "v"(lo), "v"(hi)); return r; }
__device__ __forceinline__ bf16_t f2bf(float f) { return (bf16_t)(cvt_pk_bf16(f, 0.f) & 0xffffu); }
__device__ __forceinline__ float sigmoidf_(float x) { return 1.0f / (1.0f + __expf(-x)); }
__device__ __forceinline__ float siluf_(float x) { return x / (1.0f + __expf(-x)); }
__device__ __forceinline__ float geluf_(float x) { const float u = 1.5957691216f * (x + 0.044715f * x * x * x); return x / (1.0f + __expf(-u)); }
__device__ __forceinline__ float wave_sum(float v) {
#pragma unroll
    for (int o = 1; o < 64; o <<= 1) v += __shfl_xor(v, o);
    return v;
}
__device__ __forceinline__ int rowof(int reg, int hh) { return (reg & 3) + 8 * (reg >> 2) + 4 * hh; }
__device__ __forceinline__ bf16x8 frag_row(const LAS unsigned char* base, int ldb, int row0, int k0, int lane) {
    return *(const LAS bf16x8*)(base + (row0 + (lane & 31)) * ldb + (k0 + 8 * (lane >> 5)) * 2);
}
__device__ __forceinline__ bf16x8 frag_tr(const LAS unsigned char* base, int ldb, int k0, int n0, int lane) {
    const int hh = lane >> 5, blk = (lane >> 4) & 1, q = (lane & 15) >> 2, p = lane & 3;
    const LAS unsigned char* a = base + (k0 + 8 * hh + q) * ldb + (n0 + 16 * blk + 4 * p) * 2;
    const s16x4 lo = __builtin_amdgcn_ds_read_tr16_b64_v4i16((LAS s16x4*)a);
    const s16x4 hi = __builtin_amdgcn_ds_read_tr16_b64_v4i16((LAS s16x4*)(a + 4 * ldb));
    return (bf16x8){lo[0], lo[1], lo[2], lo[3], hi[0], hi[1], hi[2], hi[3]};
}
__device__ __forceinline__ f32x16 mma32(bf16x8 a, bf16x8 b, f32x16 c) { return __builtin_amdgcn_mfma_f32_32x32x16_bf16(a, b, c, 0, 0, 0); }
__device__ __forceinline__ f32x16 zero16() { f32x16 z;
#pragma unroll
    for (int i = 0; i < 16; ++i) z[i] = 0.f;
    return z; }

#define XB_TMO      128
#define XB_XCNT(j)  (256  + 64 * (j))
#define XB_XSUB(j)  (1280 + 64 * (j))
#define XB_XGEN(j)  (2304 + 64 * (j))
#define XB_TOP      3328
#define XB_TOPGEN   3392
#define XCD_BAR_WORDS 3456
#define XB_SPIN_CAP (1u << 18)
__device__ __forceinline__ unsigned xb_ld(unsigned* p)              { return __hip_atomic_load(p, __ATOMIC_RELAXED, __HIP_MEMORY_SCOPE_AGENT); }
__device__ __forceinline__ unsigned xb_add(unsigned* p, unsigned v) { return __hip_atomic_fetch_add(p, v, __ATOMIC_RELAXED, __HIP_MEMORY_SCOPE_AGENT); }
__device__ __forceinline__ unsigned xb_xcc_id() { return (unsigned)__builtin_amdgcn_s_getreg((3 << 11) | 20) & 0xFu; }
#define XB_SPIN(cond, bar) do { unsigned _sp = 0; while (cond) { __builtin_amdgcn_s_sleep(1); \
    if ((++_sp & 255u) == 0u) { if (xb_ld(&(bar)[XB_TMO])) break; if (_sp > XB_SPIN_CAP) { atomicAdd(&(bar)[XB_TMO], 1u); break; } } } } while (0)
struct XcdBarrier { unsigned* bar; unsigned x; volatile LAS unsigned* st; };
__device__ __forceinline__ XcdBarrier xcd_barrier_post(unsigned* bar, volatile LAS unsigned* st) {
    XcdBarrier b; b.bar = bar; b.x = xb_xcc_id(); b.st = st;
    if (threadIdx.x == 0) (void)xb_add(&bar[XB_XCNT(b.x)], 1u);
    return b;
}
__device__ __forceinline__ void xcd_barrier_complete(unsigned* bar, unsigned x, unsigned& nloc, unsigned& nx) {
    const unsigned G = gridDim.x * gridDim.y * gridDim.z;
    unsigned sum, cnt, mine, sp = 0u;
    for (;;) {
        sum = 0u; cnt = 0u; mine = 0u;
#pragma unroll
        for (unsigned j = 0; j < 16; ++j) { const unsigned c = xb_ld(&bar[XB_XCNT(j)]); sum += c; cnt += (c > 0u) ? 1u : 0u; mine = (j == x) ? c : mine; }
        if (sum == G) break;
        __builtin_amdgcn_s_sleep(1);
        if ((++sp & 255u) == 0u) { if (xb_ld(&bar[XB_TMO])) break; if (sp > XB_SPIN_CAP) { atomicAdd(&bar[XB_TMO], 1u); break; } }
    }
    nloc = mine > 0u ? mine : 1u; nx = cnt > 0u ? cnt : 1u;
}
__device__ __forceinline__ void xcd_barrier(const XcdBarrier& b) {
    asm volatile("s_waitcnt vmcnt(0)" ::: "memory");
    __syncthreads();
    if (threadIdx.x == 0) {
        unsigned* bar = b.bar;
        __builtin_amdgcn_s_waitcnt(0);
        unsigned nloc = b.st[0], nx = b.st[1];
        if (nloc == 0u) { xcd_barrier_complete(bar, b.x, nloc, nx); b.st[0] = nloc; b.st[1] = nx; }
        const unsigned old = xb_add(&bar[XB_XSUB(b.x)], 1u);
        const unsigned gen = old / nloc;
        if (old + 1u == (gen + 1u) * nloc) {
            __builtin_amdgcn_fence(__ATOMIC_RELEASE, "agent");
            asm volatile("s_waitcnt vmcnt(0)" ::: "memory");
            const unsigned og = xb_add(&bar[XB_TOP], 1u);
            const unsigned tg = og / nx;
            if (og + 1u == (tg + 1u) * nx) xb_add(&bar[XB_TOPGEN], 1u);
            else XB_SPIN(xb_ld(&bar[XB_TOPGEN]) == tg, bar);
            __builtin_amdgcn_fence(__ATOMIC_ACQUIRE, "agent");
            xb_add(&bar[XB_XGEN(b.x)], 1u);
            asm volatile("s_waitcnt vmcnt(0)" ::: "memory");
        } else {
            XB_SPIN(xb_ld(&bar[XB_XGEN(b.x)]) == gen, bar);
            __builtin_amdgcn_fence(__ATOMIC_ACQUIRE, "agent");
            asm volatile("s_waitcnt vmcnt(0)" ::: "memory");
        }
    }
    __syncthreads();
}

namespace pg8 {
constexpr int BM = 256, BK = 64, HALF = 128, HTB = HALF * BK * 2, STAGE_BYTES = 8 * HTB, NXCD = 8, WGM = 8;
__device__ __forceinline__ int lds_byte(int r, int c) { const int st = (r >> 4) * 2 + (c >> 5), rr = r & 15, cc = c & 31, ob = rr * 64 + cc * 2; return st * 1024 + (ob ^ (((ob >> 9) & 1) << 5)); }
__device__ __forceinline__ void stage_rc(int b, int& R, int& C) { const int st = b / 1024, sb = b % 1024, swz = sb ^ (((sb >> 9) & 1) << 5); R = (st >> 1) * 16 + swz / 64; C = (st & 1) * 32 + (swz % 64) / 2; }
__device__ __forceinline__ int perm32(int rho) { const int n = rho >> 4, i = rho & 15; return 8 * (i >> 2) + 4 * n + (i & 3); }
struct Unit { int pm, pn; };
struct Gemm { const bf16_t* A; const bf16_t* Bt; int M, N, K; };
struct StaticOrder {
    int nM, nN, nwg, G, c;
    __device__ void init(int M, int N, int G_, int c_) { nM = M / BM; nN = N / BM; nwg = nM * nN; G = G_; c = c_; }
    __device__ bool next(int i, Unit& u) const {
        const long L = (long)i * G + c; if (L >= nwg) return false;
        int wgid = (int)L; { const int q = nwg / NXCD, r = nwg % NXCD, xcd = wgid % NXCD, off = wgid / NXCD; wgid = (xcd < r ? xcd * (q + 1) : r * (q + 1) + (xcd - r) * q) + off; }
        const int nig = WGM * nN, gid = wgid / nig, fm = gid * WGM, gsz = (nM - fm) < WGM ? (nM - fm) : WGM;
        u.pm = fm + ((wgid % nig) % gsz); u.pn = (wgid % nig) / gsz; return true;
    }
};
struct EpiP {
    static constexpr bool PERM = true;
    bf16_t* O; int ldc;
    __device__ __forceinline__ void operator()(const f32x4 (&acc)[2][2][4][2], const Unit& u, int wr, int wc, int fr, int fq) const {
        const int row0 = u.pm * BM + wr * 64 + fr, col0 = u.pn * BM + wc * 32 + 8 * fq;
#pragma unroll
        for (int ai = 0; ai < 2; ++ai)
#pragma unroll
            for (int m = 0; m < 4; ++m) { bf16_t* rowp = O + (size_t)(row0 + ai * HALF + m * 16) * ldc + col0;
#pragma unroll
                for (int bj = 0; bj < 2; ++bj) { const f32x4 v0 = acc[ai][bj][m][0], v1 = acc[ai][bj][m][1];
                    u32x4 w; w.x = cvt_pk_bf16(v0[0], v0[1]); w.y = cvt_pk_bf16(v0[2], v0[3]); w.z = cvt_pk_bf16(v1[0], v1[1]); w.w = cvt_pk_bf16(v1[2], v1[3]);
                    *(u32x4*)(rowp + bj * HALF) = w; } }
    }
};
struct EpiRes {
    static constexpr bool PERM = false;
    const float* xp; const float* xs; float* dst; const float* mod;
    __device__ __forceinline__ void operator()(const f32x4 (&acc)[2][2][4][2], const Unit& u, int wr, int wc, int fr, int fq) const {
        const int row0 = u.pm * BM + wr * 64 + fr, col0 = u.pn * BM + wc * 32 + 4 * fq;
#pragma unroll
        for (int ai = 0; ai < 2; ++ai)
#pragma unroll
            for (int m = 0; m < 4; ++m) { const int r = row0 + ai * HALF + m * 16;
                if (r < MT) {
                    const int mrow = r < MP ? (r >> 11) : 4 + (r - MP);
                    const float* xo = (r < MP ? xp + (size_t)r * D : xs + (size_t)(r - MP) * D) + col0;
                    const float* gp = mod + (size_t)mrow * NMOD + 4096 + col0;
                    float* dp = dst + (size_t)r * D + col0;
#pragma unroll
                    for (int bj = 0; bj < 2; ++bj)
#pragma unroll
                        for (int n = 0; n < 2; ++n) { const f32x4 g = *(const f32x4*)(gp + bj * HALF + n * 16); const f32x4 x = *(const f32x4*)(xo + bj * HALF + n * 16);
                            *(f32x4*)(dp + bj * HALF + n * 16) = x + g * acc[ai][bj][m][n]; } } }
    }
};

template <class Epi, class Sched>
__device__ __forceinline__ void gemm_phase(LAS unsigned char* lds, const Gemm g, const Sched& S, const Epi& E) {
    int tid = threadIdx.x; asm volatile("" : "+v"(tid));
    const int wid = __builtin_amdgcn_readfirstlane(tid >> 6), lane = tid & 63, wr = wid >> 2, wc = wid & 3, fr = lane & 15, fq = lane >> 4;
    const int K = g.K, nt = K / BK;
    unsigned voffA[2], voffB[2];
#pragma unroll
    for (int i = 0; i < 2; ++i) { int R, C; stage_rc(tid * 16 + i * 8192, R, C); const int Rb = Epi::PERM ? ((R & ~31) + perm32(R & 31)) : R;
        voffA[i] = (unsigned)(R * K + C) * 2u; voffB[i] = (unsigned)(Rb * K + C) * 2u; }
    const size_t kstep = (size_t)(BK * 2);
    const size_t hstep = (size_t)HALF * K * 2;
    const size_t tstep = 2 * hstep;
    const unsigned ldsw = (unsigned)wid * 1024u;
    const int aoff = lds_byte(wr * 64 + fr, fq * 8), boff = lds_byte(wc * 32 + fr, fq * 8);
#define PG8_SA(b, h) (((b) * 2 + (h)) * HTB)
#define PG8_SB(b, h) ((4 + (b) * 2 + (h)) * HTB)
#define PG8_STAGE(bufoff, gbase, voff) do { _Pragma("unroll") for (int _i = 0; _i < 2; ++_i) \
        __builtin_amdgcn_global_load_lds((const unsigned*)((const char*)(gbase) + (voff)[_i]), (LAS unsigned*)(lds + (bufoff) + ldsw + _i * 8192), 16, 0, 0); } while (0)
#define PG8_LDA(dst, b, h) do { _Pragma("unroll") for (int m = 0; m < 4; ++m) _Pragma("unroll") for (int k = 0; k < 2; ++k) dst[m][k] = *(const LAS bf16x8*)(lds + PG8_SA(b, h) + aoff + m * 2048 + k * 1024); } while (0)
#define PG8_LDB(dst, b, h) do { _Pragma("unroll") for (int n = 0; n < 2; ++n) _Pragma("unroll") for (int k = 0; k < 2; ++k) dst[n][k] = *(const LAS bf16x8*)(lds + PG8_SB(b, h) + boff + n * 2048 + k * 1024); } while (0)
#define PG8_MMA(ai, bj, At, Bt) do { __builtin_amdgcn_s_setprio(1); _Pragma("unroll") for (int m = 0; m < 4; ++m) _Pragma("unroll") for (int n = 0; n < 2; ++n) _Pragma("unroll") for (int k = 0; k < 2; ++k) \
        acc[ai][bj][m][n] = __builtin_amdgcn_mfma_f32_16x16x32_bf16(Bt[n][k], At[m][k], acc[ai][bj][m][n], 0, 0, 0); __builtin_amdgcn_s_setprio(0); } while (0)
#define PG8_WAIT_V(n) asm volatile("s_waitcnt vmcnt(" #n ")" ::: "memory")
#define PG8_WAIT_L(n) asm volatile("s_waitcnt lgkmcnt(" #n ")" ::: "memory")
#define PG8_BAR __builtin_amdgcn_s_barrier()
#define PG8_SCHED __builtin_amdgcn_sched_barrier(0)
    Unit cur, nxt; int ui = 0;
    if (!S.next(0, cur)) return;
    f32x4 acc[2][2][4][2];
#pragma unroll
    for (int a = 0; a < 2; ++a)
#pragma unroll
        for (int b = 0; b < 2; ++b)
#pragma unroll
            for (int m = 0; m < 4; ++m)
#pragma unroll
                for (int n = 0; n < 2; ++n) acc[a][b][m][n] = (f32x4){0.f, 0.f, 0.f, 0.f};
    bf16x8 At[4][2], B0[2][2], B1[2][2];
    const char* cA = (const char*)g.A + (size_t)cur.pm * tstep; const char* cB = (const char*)g.Bt + (size_t)cur.pn * tstep;
    PG8_STAGE(PG8_SB(0, 0), cB, voffB); PG8_STAGE(PG8_SA(0, 0), cA, voffA); PG8_STAGE(PG8_SB(0, 1), cB + hstep, voffB); PG8_STAGE(PG8_SA(0, 1), cA + hstep, voffA);
    if (wr == 1) PG8_BAR;
    PG8_WAIT_V(4); PG8_BAR;
    PG8_STAGE(PG8_SB(1, 0), cB + kstep, voffB); PG8_STAGE(PG8_SA(1, 0), cA + kstep, voffA); PG8_STAGE(PG8_SB(1, 1), cB + hstep + kstep, voffB);
    PG8_WAIT_V(6); PG8_BAR;
    for (;;) {
        const bool has_next = S.next(ui + 1, nxt);
        const char* nA = has_next ? (const char*)g.A + (size_t)nxt.pm * tstep : cA; const char* nB = has_next ? (const char*)g.Bt + (size_t)nxt.pn * tstep : cB;
        for (int t = 0; t < nt; t += 2) {
            const bool last = (t == nt - 2);
            const char* a1 = cA + (size_t)(t + 1) * kstep;
            const char* a2 = last ? nA : cA + (size_t)(t + 2) * kstep; const char* b2 = last ? nB : cB + (size_t)(t + 2) * kstep;
            const char* a3 = a2 + kstep; const char* b3 = b2 + kstep;
            PG8_LDB(B0, 0, 0); PG8_SCHED; PG8_LDA(At, 0, 0); PG8_STAGE(PG8_SA(1, 1), a1 + hstep, voffA);
            PG8_WAIT_L(8); PG8_BAR; PG8_WAIT_L(0); PG8_MMA(0, 0, At, B0); PG8_BAR; PG8_SCHED;
            PG8_LDB(B1, 0, 1); PG8_STAGE(PG8_SB(0, 0), b2, voffB);
            PG8_BAR; PG8_WAIT_L(0); PG8_MMA(0, 1, At, B1); PG8_BAR;
            PG8_LDA(At, 0, 1); PG8_STAGE(PG8_SA(0, 0), a2, voffA);
            PG8_BAR; PG8_WAIT_L(0); PG8_MMA(1, 0, At, B0); PG8_BAR; PG8_SCHED;
            PG8_STAGE(PG8_SB(0, 1), b2 + hstep, voffB);
            PG8_WAIT_V(6); PG8_BAR; PG8_MMA(1, 1, At, B1); PG8_BAR;
            PG8_LDB(B0, 1, 0); PG8_SCHED; PG8_LDA(At, 1, 0); PG8_STAGE(PG8_SA(0, 1), a2 + hstep, voffA);
            PG8_WAIT_L(8); PG8_BAR; PG8_WAIT_L(0); PG8_MMA(0, 0, At, B0); PG8_BAR; PG8_SCHED;
            PG8_LDB(B1, 1, 1); PG8_STAGE(PG8_SB(1, 0), b3, voffB);
            PG8_BAR; PG8_WAIT_L(0); PG8_MMA(0, 1, At, B1); PG8_BAR;
            PG8_LDA(At, 1, 1); PG8_STAGE(PG8_SA(1, 0), a3, voffA);
            PG8_BAR; PG8_WAIT_L(0); PG8_MMA(1, 0, At, B0); PG8_BAR; PG8_SCHED;
            PG8_STAGE(PG8_SB(1, 1), b3 + hstep, voffB);
            PG8_WAIT_V(6); PG8_BAR; PG8_MMA(1, 1, At, B1); PG8_BAR;
        }
        E(acc, cur, wr, wc, fr, fq);
        if (!has_next) break;
#pragma unroll
        for (int a = 0; a < 2; ++a)
#pragma unroll
            for (int b = 0; b < 2; ++b)
#pragma unroll
                for (int m = 0; m < 4; ++m)
#pragma unroll
                    for (int n = 0; n < 2; ++n) acc[a][b][m][n] = (f32x4){0.f, 0.f, 0.f, 0.f};
        cur = nxt; cA = nA; cB = nB; ++ui;
    }
    PG8_WAIT_V(0);
    if (wr == 0) PG8_BAR;
    PG8_BAR;
#undef PG8_SA
#undef PG8_SB
#undef PG8_STAGE
#undef PG8_LDA
#undef PG8_LDB
#undef PG8_MMA
#undef PG8_WAIT_V
#undef PG8_WAIT_L
#undef PG8_BAR
#undef PG8_SCHED
}
}

template <int MODE>
__device__ __forceinline__ void skinny_item(const Args& a, int l, int n0, const bf16_t* Arows, const bf16_t* Bt, LAS unsigned char* lds, int tid, int lane, int wave) {
    LAS float* red = (LAS float*)lds;
    const int r = lane & 31, hh = lane >> 5;
    f32x16 acc[4];
#pragma unroll
    for (int i = 0; i < 4; ++i) acc[i] = zero16();
    const bf16_t* bp = Bt + (size_t)(n0 + r) * D + wave * 256 + 8 * hh;
    const bf16_t* ap = Arows + (size_t)r * D + wave * 256 + 8 * hh;
#pragma unroll 4
    for (int ks = 0; ks < 16; ++ks) { const bf16x8 bf = *(const bf16x8*)(bp + ks * 16);
#pragma unroll
        for (int rb = 0; rb < 4; ++rb) { const bf16x8 af = *(const bf16x8*)(ap + (size_t)rb * 32 * D + ks * 16); acc[rb] = mma32(bf, af, acc[rb]); } }
#pragma unroll
    for (int rb = 0; rb < 4; ++rb)
#pragma unroll
        for (int reg = 0; reg < 16; ++reg) red[((wave * 4 + rb) * 16 + reg) * 64 + lane] = acc[rb][reg];
    __syncthreads();
#pragma unroll
    for (int i = 0; i < 8; ++i) { const int e = tid + 512 * i; float sum = 0.f;
#pragma unroll
        for (int w = 0; w < 8; ++w) sum += red[w * 4096 + e];
        const int rb = e >> 10, reg = (e >> 6) & 15, ln = e & 63; const int m = rb * 32 + (ln & 31), n = n0 + rowof(reg, ln >> 5);
        if (MODE == 0) ((bf16_t*)(a.ws + WS_P))[(size_t)(MP + m) * NB + n] = f2bf(sum);
        else { const float* xs = l == 0 ? a.in[1] : (const float*)(a.ws + WS_X1) + (size_t)MP * D; float* dst = (l == 0 ? (float*)(a.ws + WS_X1) : a.out + OY) + (size_t)MP * D;
            const float gate = ((const float*)(a.ws + WS_MOD))[((size_t)l * NCR + 4 + m) * NMOD + 4096 + n];
            dst[(size_t)m * D + n] = xs[(size_t)m * D + n] + gate * sum; } }
    __syncthreads();
}

__device__ __forceinline__ void transpose_item(const float* W, int ldw, int nblk, bf16_t* WT, int K, int item, bool remap, LAS float* scr, int lane) {
    const int kb = item / nblk, nb = item % nblk, k0 = 64 * kb, n0 = 32 * nb;
    const int n0s = (remap && n0 >= 5120) ? n0 + 8 : n0;
#pragma unroll 8
    for (int i = 0; i < 32; ++i) { const int kk = 2 * i + (lane >> 5); scr[kk * 33 + (lane & 31)] = W[(size_t)(k0 + kk) * ldw + n0s + (lane & 31)]; }
    asm volatile("s_waitcnt lgkmcnt(0)" ::: "memory");
    const int c = lane & 7;
#pragma unroll
    for (int j = 0; j < 4; ++j) { const int n = (lane >> 3) + 8 * j; const LAS float* s = scr + (8 * c) * 33 + n;
        u32x4 o; o.x = cvt_pk_bf16(s[0 * 33], s[1 * 33]); o.y = cvt_pk_bf16(s[2 * 33], s[3 * 33]); o.z = cvt_pk_bf16(s[4 * 33], s[5 * 33]); o.w = cvt_pk_bf16(s[6 * 33], s[7 * 33]);
        *(u32x4*)(WT + (size_t)(n0 + n) * K + k0 + 8 * c) = o; }
    asm volatile("s_waitcnt lgkmcnt(0)" ::: "memory");
}
__device__ __forceinline__ void phase0(const Args& a, LAS unsigned char* lds, int tid, int lane, int wave, int G, int bid) {
    bf16_t* SC = (bf16_t*)(a.ws + WS_SC);
    const float* cp = a.in[5]; const float* cs = a.in[6];
    for (int i = bid * 512 + tid; i < 160 * 512; i += G * 512) {
        const int r = i >> 9, c4 = (i & 511) * 4;
        f32x4 v = (f32x4){0.f, 0.f, 0.f, 0.f};
        if (r < 4) v = *(const f32x4*)(cp + (size_t)r * D + c4); else if (r < NCR) v = *(const f32x4*)(cs + (size_t)(r - 4) * D + c4);
        u32x2 o; o.x = cvt_pk_bf16(siluf_(v[0]), siluf_(v[1])); o.y = cvt_pk_bf16(siluf_(v[2]), siluf_(v[3]));
        *(u32x2*)(SC + (size_t)r * D + c4) = o;
    }
    LAS float* scr = (LAS float*)(lds + wave * 8448);
    const int gw = bid * 8 + wave, NGW = G * 8;
    constexpr int I_IN = 32 * 256, I_OUT = 32 * 64;
    for (int it = gw; it < 2 * I_IN + 2 * I_OUT; it += NGW) {
        if (it < 2 * I_IN) { const int l = it / I_IN, r = it % I_IN;
            transpose_item(a.in[10] + (size_t)l * D * DIN, DIN, 256, (bf16_t*)(a.ws + WS_WIN) + (size_t)l * NB * D, D, r, true, scr, lane); }
        else { const int j = it - 2 * I_IN, l = j / I_OUT, r = j % I_OUT;
            transpose_item(a.in[17] + (size_t)l * D * D, D, 64, (bf16_t*)(a.ws + WS_WOUT) + (size_t)l * D * D, D, r, false, scr, lane); }
    }
}

__device__ __forceinline__ void phase_ada(const Args& a, LAS unsigned char* lds, int tid, int lane, int wave, int G, int bid) {
    const bf16_t* SC = (const bf16_t*)(a.ws + WS_SC);
    float* MOD = (float*)(a.ws + WS_MOD);
    LAS float* red = (LAS float*)lds;
    const int r = lane & 31, hh = lane >> 5;
    for (int item = bid; item < 384; item += G) {
        const int l = item / 192, n0 = (item % 192) * 32;
        const float* W = a.in[8] + (size_t)l * D * NMOD;
        const int kbase = wave * 256;
        f32x16 acc[5];
#pragma unroll
        for (int i = 0; i < 5; ++i) acc[i] = zero16();
#pragma unroll 2
        for (int ks = 0; ks < 16; ++ks) {
            const int k0 = kbase + ks * 16;
            const float* wp = W + (size_t)(k0 + 8 * hh) * NMOD + n0 + r;
            float wv[8];
#pragma unroll
            for (int j = 0; j < 8; ++j) wv[j] = wp[(size_t)j * NMOD];
            union { u32x4 u; bf16x8 v; } bfr;
            bfr.u.x = cvt_pk_bf16(wv[0], wv[1]); bfr.u.y = cvt_pk_bf16(wv[2], wv[3]); bfr.u.z = cvt_pk_bf16(wv[4], wv[5]); bfr.u.w = cvt_pk_bf16(wv[6], wv[7]);
#pragma unroll
            for (int rb = 0; rb < 5; ++rb) { const bf16x8 af = *(const bf16x8*)(SC + (size_t)(rb * 32 + r) * D + k0 + 8 * hh); acc[rb] = mma32(af, bfr.v, acc[rb]); }
        }
#pragma unroll
        for (int rb = 0; rb < 5; ++rb) {
#pragma unroll
            for (int reg = 0; reg < 16; ++reg) red[wave * 1024 + reg * 64 + lane] = acc[rb][reg];
            __syncthreads();
#pragma unroll
            for (int e2 = 0; e2 < 2; ++e2) { const int e = tid + e2 * 512; float s = 0.f;
#pragma unroll
                for (int w = 0; w < 8; ++w) s += red[w * 1024 + e];
                const int reg = e >> 6, ln = e & 63; const int row = rb * 32 + rowof(reg, ln >> 5), col = n0 + (ln & 31);
                if (row < NCR) MOD[((size_t)l * NCR + row) * NMOD + col] = s + a.in[9][(size_t)l * NMOD + col]; }
            __syncthreads();
        }
    }
}

__device__ __forceinline__ void phase_norm(const Args& a, int l, LAS unsigned char* lds, int tid, int lane, int wave, int G, int bid) {
    LAS float* Wg = (LAS float*)lds;
    const float* win = a.in[10] + (size_t)l * D * DIN;
    for (int k = tid; k < D; k += 512) { const f32x4 w0 = *(const f32x4*)(win + (size_t)k * DIN + 5120), w1 = *(const f32x4*)(win + (size_t)k * DIN + 5124);
        Wg[0 * D + k] = w0[0]; Wg[1 * D + k] = w0[1]; Wg[2 * D + k] = w0[2]; Wg[3 * D + k] = w0[3];
        Wg[4 * D + k] = w1[0]; Wg[5 * D + k] = w1[1]; Wg[6 * D + k] = w1[2]; Wg[7 * D + k] = w1[3]; }
    __syncthreads();
    const float* xp = l == 0 ? a.in[0] : (const float*)(a.ws + WS_X1);
    const float* xs = l == 0 ? a.in[1] : (const float*)(a.ws + WS_X1) + (size_t)MP * D;
    const float* gn = a.in[7] + (size_t)l * D;
    const float* MOD = (const float*)(a.ws + WS_MOD) + (size_t)l * NCR * NMOD;
    bf16_t* HN = (bf16_t*)(a.ws + WS_HN);
    float* IG = (float*)(a.ws + WS_IG); float* LF = (float*)(a.ws + WS_LF);
    for (int r = bid * 8 + wave; r < MT; r += G * 8) {
        const float* xr = (r < MP ? xp + (size_t)r * D : xs + (size_t)(r - MP) * D) + lane * 4;
        const int mrow = r < MP ? (r >> 11) : 4 + (r - MP);
        const float* mp = MOD + (size_t)mrow * NMOD + lane * 4;
        f32x4 v[8]; float ss = 0.f;
#pragma unroll
        for (int i = 0; i < 8; ++i) { v[i] = *(const f32x4*)(xr + 256 * i); ss += (v[i][0] * v[i][0] + v[i][1] * v[i][1]) + (v[i][2] * v[i][2] + v[i][3] * v[i][3]); }
        const float rstd = rsqrtf(wave_sum(ss) * (1.0f / D) + EPS);
        float gd[8];
#pragma unroll
        for (int j = 0; j < 8; ++j) gd[j] = 0.f;
#pragma unroll
        for (int i = 0; i < 8; ++i) {
            const f32x4 g = *(const f32x4*)(gn + lane * 4 + 256 * i), sh = *(const f32x4*)(mp + 256 * i), sc = *(const f32x4*)(mp + 2048 + 256 * i);
            const f32x4 hv = v[i] * rstd * g * (sc + 1.0f) + sh;
            u32x2 o; o.x = cvt_pk_bf16(hv[0], hv[1]); o.y = cvt_pk_bf16(hv[2], hv[3]);
            *(u32x2*)(HN + (size_t)r * D + lane * 4 + 256 * i) = o;
#pragma unroll
            for (int j = 0; j < 8; ++j) { const f32x4 w = *(const LAS f32x4*)(Wg + j * D + lane * 4 + 256 * i); gd[j] += (hv[0] * w[0] + hv[1] * w[1]) + (hv[2] * w[2] + hv[3] * w[3]); }
        }
#pragma unroll
        for (int j = 0; j < 8; ++j) gd[j] = wave_sum(gd[j]);
        if (lane < 4) {
            const float gi = lane == 0 ? gd[0] : lane == 1 ? gd[1] : lane == 2 ? gd[2] : gd[3];
            const float gf = lane == 0 ? gd[4] : lane == 1 ? gd[5] : lane == 2 ? gd[6] : gd[7];
            IG[r * 4 + lane] = gi + a.in[11][l * 4 + lane];
            const float f = gf + a.in[12][l * 4 + lane];
            LF[r * 4 + lane] = fminf(f, 0.f) - log1pf(expf(-fabsf(f)));
        }
    }
    __syncthreads();
}

__device__ __forceinline__ void chunk_scan(const float* IG, const float* LF, int r0, int h, int lane, float& b0, float& b1, float& e0, float& e1, float& cm0, float& cm1) {
    const float lf0 = LF[(r0 + 2 * lane) * 4 + h], lf1 = LF[(r0 + 2 * lane + 1) * 4 + h];
    const float ig0 = IG[(r0 + 2 * lane) * 4 + h], ig1 = IG[(r0 + 2 * lane + 1) * 4 + h];
    float s = lf0 + lf1;
#pragma unroll
    for (int o = 1; o < 64; o <<= 1) { const float t = __shfl_up(s, o); if (lane >= o) s += t; }
    b1 = s; b0 = s - lf1;
    e0 = ig0 - b0; e1 = ig1 - b1;
    float mx = fmaxf(e0, e1);
#pragma unroll
    for (int o = 1; o < 64; o <<= 1) { const float t = __shfl_up(mx, o); if (lane >= o) mx = fmaxf(mx, t); }
    cm1 = mx;
    const float prev = __shfl_up(mx, 1);
    cm0 = lane > 0 ? fmaxf(prev, e0) : e0;
}

__device__ __forceinline__ void scan_item(const Args& a, int l, int item, LAS unsigned char* lds, int tid, int lane, int wave) {
    const int bh = item >> 3, vt = (item >> 2) & 1, dt = item & 3, b = bh >> 2, h = bh & 3;
    LAS unsigned char* Vt = lds;
    LAS unsigned char* Kt = lds + 34816;
    LAS float* E = (LAS float*)(lds + 53248);
    LAS float* Gs = E + 2048;
    LAS float* Bc = Gs + 2048; LAS float* CMX = Bc + 16; LAS float* MC = CMX + 16; LAS float* DEC = MC + 32;
    const float* IG = (const float*)(a.ws + WS_IG); const float* LF = (const float*)(a.ws + WS_LF);
    const bf16_t* P = (const bf16_t*)(a.ws + WS_P);
    bf16_t* CST = (bf16_t*)(a.ws + WS_CST); float* NST = (float*)(a.ws + WS_NST); float* MST = (float*)(a.ws + WS_MST);
#pragma unroll
    for (int j = 0; j < 2; ++j) { const int cc = 2 * wave + j; float b0, b1, e0, e1, cm0, cm1;
        chunk_scan(IG, LF, b * 2048 + cc * 128, h, lane, b0, b1, e0, e1, cm0, cm1);
        E[cc * 128 + 2 * lane] = e0; E[cc * 128 + 2 * lane + 1] = e1;
        if (lane == 63) { Bc[cc] = b1; CMX[cc] = cm1; } }
    __syncthreads();
    if (tid == 0) { float m = 0.f;
        for (int cc = 0; cc < 16; ++cc) { MC[cc] = m; const float mn = Bc[cc] + fmaxf(m, CMX[cc]); DEC[cc] = __expf(Bc[cc] + m - mn); m = mn; }
        MC[16] = m; }
    __syncthreads();
    for (int t = tid; t < 2048; t += 512) { const int cc = t >> 7; Gs[t] = __expf(Bc[cc] + E[t] - MC[cc + 1]) * 0.0625f; }
    if (vt == 0 && dt == 0) { if (tid < 16) MST[bh * 16 + tid] = MC[tid]; if (tid == 0) a.out[OMP + l * 16 + bh] = MC[16]; }
    f32x16 acc = zero16(), nblk = zero16();
    const int vb = wave >> 1, db = wave & 1, r = lane & 31, hh = lane >> 5;
    const bool nwave = (vt == 0 && vb == 0);
    u32x4 vrA[4], krA[2], vrB[4], krB[2];
#define SCAN_LOAD(vr, kr, cc) do { const int r0_ = b * 2048 + (cc) * 128; \
        _Pragma("unroll") for (int i2 = 0; i2 < 4; ++i2) { const int i = tid + i2 * 512, s_ = i >> 4, ch = i & 15; vr[i2] = *(const u32x4*)(P + (size_t)(r0_ + s_) * NB + 2048 + h * 256 + vt * 128 + ch * 8); } \
        _Pragma("unroll") for (int i2 = 0; i2 < 2; ++i2) { const int i = tid + i2 * 512, s_ = i >> 3, ch = i & 7; kr[i2] = *(const u32x4*)(P + (size_t)(r0_ + s_) * NB + 1024 + h * 256 + dt * 64 + ch * 8); } } while (0)
#define SCAN_STEP(vr, kr, c) do { \
        { bf16_t* cp_ = CST + ((size_t)(bh * 16 + (c)) * 256 + vt * 128 + vb * 32 + r) * 256 + dt * 64 + db * 32 + 4 * hh; \
          _Pragma("unroll") for (int q4 = 0; q4 < 4; ++q4) { u32x2 o; o.x = cvt_pk_bf16(acc[4 * q4 + 0], acc[4 * q4 + 1]); o.y = cvt_pk_bf16(acc[4 * q4 + 2], acc[4 * q4 + 3]); *(u32x2*)(cp_ + 8 * q4) = o; } } \
        if (nwave && r == 0) { _Pragma("unroll") for (int reg = 0; reg < 16; ++reg) NST[(bh * 16 + (c)) * 256 + dt * 64 + db * 32 + rowof(reg, hh)] = nblk[reg]; } \
        __syncthreads(); \
        _Pragma("unroll") for (int i2 = 0; i2 < 4; ++i2) { const int i = tid + i2 * 512, s_ = i >> 4, ch = i & 15; \
            const u32x4 raw = vr[i2]; const float g = Gs[(c) * 128 + s_]; \
            u32x4 o; o.x = cvt_pk_bf16(bflo(raw.x) * g, bfhi(raw.x) * g); o.y = cvt_pk_bf16(bflo(raw.y) * g, bfhi(raw.y) * g); \
            o.z = cvt_pk_bf16(bflo(raw.z) * g, bfhi(raw.z) * g); o.w = cvt_pk_bf16(bflo(raw.w) * g, bfhi(raw.w) * g); \
            *(LAS u32x4*)(Vt + s_ * 272 + ch * 16) = o; } \
        if (tid < 128) { u32x4 o; o.x = cvt_pk_bf16(Gs[(c) * 128 + tid], 0.f); o.y = 0u; o.z = 0u; o.w = 0u; *(LAS u32x4*)(Vt + tid * 272 + 256) = o; } \
        _Pragma("unroll") for (int i2 = 0; i2 < 2; ++i2) { const int i = tid + i2 * 512, s_ = i >> 3, ch = i & 7; *(LAS u32x4*)(Kt + s_ * 144 + ch * 16) = kr[i2]; } \
        if ((c) + 2 < 16) SCAN_LOAD(vr, kr, (c) + 2); \
        __syncthreads(); \
        { const float dec = DEC[(c)]; \
          _Pragma("unroll") for (int reg = 0; reg < 16; ++reg) { acc[reg] *= dec; nblk[reg] *= dec; } } \
        if (nwave) { \
            _Pragma("unroll") for (int ks = 0; ks < 8; ++ks) { const bf16x8 vf = frag_tr(Vt, 272, ks * 16, vb * 32, lane); const bf16x8 kf = frag_tr(Kt, 144, ks * 16, db * 32, lane); const bf16x8 gf = frag_tr(Vt, 272, ks * 16, 128, lane); \
                acc = mma32(kf, vf, acc); nblk = mma32(kf, gf, nblk); } \
        } else { \
            _Pragma("unroll") for (int ks = 0; ks < 8; ++ks) { const bf16x8 vf = frag_tr(Vt, 272, ks * 16, vb * 32, lane); const bf16x8 kf = frag_tr(Kt, 144, ks * 16, db * 32, lane); acc = mma32(kf, vf, acc); } \
        } } while (0)
    SCAN_LOAD(vrA, krA, 0); SCAN_LOAD(vrB, krB, 1);
#pragma unroll 1
    for (int c = 0; c < 16; c += 2) { SCAN_STEP(vrA, krA, c); SCAN_STEP(vrB, krB, c + 1); }
#undef SCAN_LOAD
#undef SCAN_STEP
    { float* op_ = a.out + OCP + ((size_t)(l * 16 + bh) * 256 + vt * 128 + vb * 32 + r) * 256 + dt * 64 + db * 32 + 4 * hh;
#pragma unroll
      for (int q4 = 0; q4 < 4; ++q4) *(f32x4*)(op_ + 8 * q4) = (f32x4){acc[4 * q4 + 0], acc[4 * q4 + 1], acc[4 * q4 + 2], acc[4 * q4 + 3]}; }
    if (nwave && r == 0) {
#pragma unroll
        for (int reg = 0; reg < 16; ++reg) a.out[ONP + (l * 16 + bh) * 256 + dt * 64 + db * 32 + rowof(reg, hh)] = nblk[reg]; }
    __syncthreads();
}

__device__ __forceinline__ void mix_item(const Args& a, int l, int item, LAS unsigned char* lds, int tid, int lane, int wave) {
    const int b = item >> 6, c = (item >> 2) & 15, g = item & 3, r0 = b * 2048 + c * 128;
    LAS unsigned char* VN = lds;
    LAS unsigned char* WW = lds + 67584;
    const bf16_t* P = (const bf16_t*)(a.ws + WS_P);
    bf16_t* ACT = (bf16_t*)(a.ws + WS_ACT);
    const float* ws_ = a.in[15] + (size_t)(l * 4 + g) * 128 * 128;
#pragma unroll
    for (int i2 = 0; i2 < 8; ++i2) { const int i = tid + i2 * 512, t = i >> 5, s4 = (i & 31) * 4;
        f32x4 w = *(const f32x4*)(ws_ + t * 128 + s4);
        if (s4 + 0 > t) w[0] = 0.f; if (s4 + 1 > t) w[1] = 0.f; if (s4 + 2 > t) w[2] = 0.f; if (s4 + 3 > t) w[3] = 0.f;
        u32x2 o; o.x = cvt_pk_bf16(w[0], w[1]); o.y = cvt_pk_bf16(w[2], w[3]);
        *(LAS u32x2*)(WW + t * 272 + s4 * 2) = o; }
    const f32x4 gc = *(const f32x4*)(a.in[14] + l * 1024 + g * 256 + lane * 4);
    u32x2 vraw[16];
#pragma unroll
    for (int i = 0; i < 16; ++i) vraw[i] = *(const u32x2*)(P + (size_t)(r0 + wave * 16 + i) * NB + 6144 + g * 256 + lane * 4);
#pragma unroll
    for (int i = 0; i < 16; ++i) { const int s = wave * 16 + i;
        const u32x2 raw = vraw[i];
        float x0 = geluf_(bflo(raw.x)), x1 = geluf_(bfhi(raw.x)), x2 = geluf_(bflo(raw.y)), x3 = geluf_(bfhi(raw.y));
        const float mean = wave_sum((x0 + x1) + (x2 + x3)) * (1.0f / 256.0f);
        x0 -= mean; x1 -= mean; x2 -= mean; x3 -= mean;
        const float rstd = rsqrtf(wave_sum((x0 * x0 + x1 * x1) + (x2 * x2 + x3 * x3)) * (1.0f / 256.0f) + EPS);
        u32x2 o; o.x = cvt_pk_bf16(x0 * rstd * gc[0], x1 * rstd * gc[1]); o.y = cvt_pk_bf16(x2 * rstd * gc[2], x3 * rstd * gc[3]);
        *(LAS u32x2*)(VN + s * 528 + lane * 8) = o; }
    __syncthreads();
    const int tb = wave >> 1, cb0 = (wave & 1) * 4, r = lane & 31, hh = lane >> 5;
    f32x16 acc[4];
#pragma unroll
    for (int j = 0; j < 4; ++j) acc[j] = zero16();
    for (int ks = 0; ks < 2 * (tb + 1); ++ks) { const bf16x8 wf = frag_row(WW, 272, tb * 32, ks * 16, lane);
#pragma unroll
        for (int j = 0; j < 4; ++j) { const bf16x8 vf = frag_tr(VN, 528, ks * 16, (cb0 + j) * 32, lane); acc[j] = mma32(vf, wf, acc[j]); } }
    { const int t = tb * 32 + r; const float bias = a.in[16][(l * 4 + g) * 128 + t];
      const bf16_t* prow = P + (size_t)(r0 + t) * NB + g * 256 + 4 * hh; bf16_t* arow = ACT + (size_t)(r0 + t) * D + 1024 + g * 256 + 4 * hh;
#pragma unroll
      for (int j = 0; j < 4; ++j)
#pragma unroll
        for (int q4 = 0; q4 < 4; ++q4) { const int chb = (cb0 + j) * 32 + 8 * q4;
            const u32x2 ur = *(const u32x2*)(prow + 5120 + chb), zr = *(const u32x2*)(prow + 7168 + chb);
            const float o0 = geluf_(bflo(ur.x)) * (acc[j][4 * q4 + 0] + bias) * siluf_(bflo(zr.x)), o1 = geluf_(bfhi(ur.x)) * (acc[j][4 * q4 + 1] + bias) * siluf_(bfhi(zr.x));
            const float o2 = geluf_(bflo(ur.y)) * (acc[j][4 * q4 + 2] + bias) * siluf_(bflo(zr.y)), o3 = geluf_(bfhi(ur.y)) * (acc[j][4 * q4 + 3] + bias) * siluf_(bfhi(zr.y));
            u32x2 o; o.x = cvt_pk_bf16(o0, o1); o.y = cvt_pk_bf16(o2, o3); *(u32x2*)(arow + chb) = o; } }
    __syncthreads();
}

__device__ __forceinline__ void sample_item(const Args& a, int l, int item, LAS unsigned char* lds, int tid, int lane, int wave) {
    const int rr = item >> 2, h = item & 3, R = MP + rr;
    LAS float* q = (LAS float*)lds; LAS float* k = q + 256; LAS float* vv = q + 512; LAS float* n0 = q + 768; LAS float* CQ = q + 1024; LAS float* HH = q + 1280; LAS float* RED = q + 1536;
    const bf16_t* P = (const bf16_t*)(a.ws + WS_P);
    bf16_t* ACT = (bf16_t*)(a.ws + WS_ACT);
    const bf16_t* prow = P + (size_t)R * NB;
    const size_t sidx = (size_t)(l * 128 + rr) * 4 + h;
    if (tid < 256) { q[tid] = bf2f(prow[h * 256 + tid]); k[tid] = bf2f(prow[1024 + h * 256 + tid]) * 0.0625f; vv[tid] = bf2f(prow[2048 + h * 256 + tid]); n0[tid] = a.in[3][sidx * 256 + tid]; }
    __syncthreads();
    const float ig = ((const float*)(a.ws + WS_IG))[R * 4 + h], lf = ((const float*)(a.ws + WS_LF))[R * 4 + h], m0 = a.in[4][sidx];
    const float a_ = lf + m0, mt = fmaxf(a_, ig), wintra = __expf(ig - mt), winter = __expf(a_ - mt);
    const f32x4 q4 = *(const LAS f32x4*)(q + lane * 4), k4 = *(const LAS f32x4*)(k + lane * 4), n4 = *(const LAS f32x4*)(n0 + lane * 4);
    const float qk = wave_sum((q4[0] * k4[0] + q4[1] * k4[1]) + (q4[2] * k4[2] + q4[3] * k4[3]));
    const float nq = wave_sum((q4[0] * n4[0] + q4[1] * n4[1]) + (q4[2] * n4[2] + q4[3] * n4[3]));
    const float s = qk * wintra, den = winter * nq + s, inv = 1.0f / fmaxf(fabsf(den), __expf(-mt));
    const float* C0 = a.in[2] + sidx * 65536; float* C1 = a.out + OCS + sidx * 65536;
#pragma unroll 1
    for (int i0 = 0; i0 < 32; i0 += 16) {
        f32x4 c4[16];
#pragma unroll
        for (int i = 0; i < 16; ++i) c4[i] = __builtin_nontemporal_load((const f32x4*)(C0 + (size_t)(wave * 32 + i0 + i) * 256 + lane * 4));
#pragma unroll
        for (int i = 0; i < 16; ++i) { const int vrow = wave * 32 + i0 + i;
            float dot = (c4[i][0] * q4[0] + c4[i][1] * q4[1]) + (c4[i][2] * q4[2] + c4[i][3] * q4[3]);
            const float gv = wintra * vv[vrow];
            const f32x4 cn = c4[i] * winter + k4 * gv;
            __builtin_nontemporal_store(cn, (f32x4*)(C1 + (size_t)vrow * 256 + lane * 4));
            dot = wave_sum(dot); if (lane == 0) CQ[vrow] = dot; } }
    __syncthreads();
    float hv = 0.f, xg = 0.f;
    if (tid < 256) { const float num = winter * CQ[tid] + s * vv[tid]; hv = num * inv * sigmoidf_(bf2f(prow[3072 + h * 256 + tid])); HH[tid] = hv;
        a.out[ONS + sidx * 256 + tid] = winter * n0[tid] + wintra * k[tid];
        const float p = wave_sum(hv * hv); if (lane == 0) RED[wave] = p; }
    else { xg = geluf_(bf2f(prow[6144 + h * 256 + (tid - 256)])); const float p = wave_sum(xg); if (lane == 0) RED[wave] = p; }
    if (tid == 0) a.out[OMS + sidx] = mt;
    __syncthreads();
    if (tid < 256) { const float rstd = rsqrtf(((RED[0] + RED[1]) + (RED[2] + RED[3])) * (1.0f / 256.0f) + EPS);
        ACT[(size_t)R * D + h * 256 + tid] = f2bf(hv * rstd * a.in[13][l * 1024 + h * 256 + tid] * siluf_(bf2f(prow[4096 + h * 256 + tid]))); }
    else { const float mean = ((RED[4] + RED[5]) + (RED[6] + RED[7])) * (1.0f / 256.0f); xg -= mean; const float p = wave_sum(xg * xg); if (lane == 0) RED[4 + wave] = p; }
    __syncthreads();
    if (tid >= 256) { const int ch = tid - 256; const float rstd = rsqrtf(((RED[8] + RED[9]) + (RED[10] + RED[11])) * (1.0f / 256.0f) + EPS);
        const float vn = xg * rstd * a.in[14][l * 1024 + h * 256 + ch];
        a.out[OVS + (size_t)(l * 128 + rr) * 1024 + h * 256 + ch] = vn;
        const float w00 = a.in[15][(size_t)(l * 4 + h) * 16384], b0 = a.in[16][(l * 4 + h) * 128];
        ACT[(size_t)R * D + 1024 + h * 256 + ch] = f2bf(geluf_(bf2f(prow[5120 + h * 256 + ch])) * (w00 * vn + b0) * siluf_(bf2f(prow[7168 + h * 256 + ch]))); }
    __syncthreads();
}

__device__ __forceinline__ void mlstm_out_item(const Args& a, int l, int item, LAS unsigned char* lds, int tid, int lane, int wave) {
    const int bh = item >> 4, c = item & 15, b = bh >> 2, h = bh & 3, r0 = b * 2048 + c * 128;
    LAS unsigned char* KC = lds;
    LAS unsigned char* SS = lds + 67584;
    LAS unsigned char* VV = lds + 67584 + 34816;
    LAS float* SM = (LAS float*)(lds + 137216);
    LAS float* E = SM; LAS float* MX = SM + 128; LAS float* BT = SM + 256; LAS float* NQ = SM + 384; LAS float* INV = SM + 512; LAS float* WI = SM + 640; LAS float* SSQ = SM + 768; LAS float* NV = SM + 1024;
    const bf16_t* P = (const bf16_t*)(a.ws + WS_P);
    bf16_t* ACT = (bf16_t*)(a.ws + WS_ACT);
    const bf16_t* CST = (const bf16_t*)(a.ws + WS_CST) + (size_t)(bh * 16 + c) * 65536;
    const int tb = wave >> 1, sub = wave & 1, r = lane & 31, hh = lane >> 5;
    const float m_c = ((const float*)(a.ws + WS_MST))[bh * 16 + c];
    if (wave == 0) { float b0, b1, e0, e1, cm0, cm1;
        chunk_scan((const float*)(a.ws + WS_IG), (const float*)(a.ws + WS_LF), r0, h, lane, b0, b1, e0, e1, cm0, cm1);
        E[2 * lane] = e0; E[2 * lane + 1] = e1; MX[2 * lane] = fmaxf(m_c, cm0); MX[2 * lane + 1] = fmaxf(m_c, cm1); BT[2 * lane] = b0; BT[2 * lane + 1] = b1; }
    if (tid < 256) NV[tid] = ((const float*)(a.ws + WS_NST))[(bh * 16 + c) * 256 + tid];
#pragma unroll
    for (int i2 = 0; i2 < 8; ++i2) { const int i = tid + i2 * 512, s = i >> 5, ch = i & 31;
        *(LAS u32x4*)(KC + s * 528 + ch * 16) = *(const u32x4*)(P + (size_t)(r0 + s) * NB + 1024 + h * 256 + ch * 8); }
    bf16x8 qf[16];
    { const bf16_t* qrow = P + (size_t)(r0 + tb * 32 + r) * NB + h * 256 + 8 * hh;
#pragma unroll
      for (int ks = 0; ks < 16; ++ks) qf[ks] = *(const bf16x8*)(qrow + ks * 16); }
    __syncthreads();
    u32x4 vpre[4], cpre[8];
#define MO_LOAD(hv_) do { \
        _Pragma("unroll") for (int i2 = 0; i2 < 4; ++i2) { const int i = tid + i2 * 512, s_ = i >> 4, ch = i & 15; vpre[i2] = *(const u32x4*)(P + (size_t)(r0 + s_) * NB + 2048 + h * 256 + (hv_) * 128 + ch * 8); } \
        _Pragma("unroll") for (int i2 = 0; i2 < 8; ++i2) { const int i = tid + i2 * 512, v_ = i >> 5, ch = i & 31; cpre[i2] = *(const u32x4*)(CST + (size_t)((hv_) * 128 + v_) * 256 + ch * 8); } } while (0)
#define MO_STORE() do { \
        _Pragma("unroll") for (int i2 = 0; i2 < 4; ++i2) { const int i = tid + i2 * 512, s_ = i >> 4, ch = i & 15; *(LAS u32x4*)(VV + s_ * 272 + ch * 16) = vpre[i2]; } \
        _Pragma("unroll") for (int i2 = 0; i2 < 8; ++i2) { const int i = tid + i2 * 512, v_ = i >> 5, ch = i & 31; *(LAS u32x4*)(KC + v_ * 528 + ch * 16) = cpre[i2]; } } while (0)
    MO_LOAD(0);
    if (sub == 0) { float p = 0.f;
#pragma unroll
        for (int ks = 0; ks < 16; ++ks)
#pragma unroll
            for (int j = 0; j < 8; ++j) p += bf2f((bf16_t)qf[ks][j]) * NV[16 * ks + 8 * hh + j];
        p += __shfl_xor(p, 32); if (hh == 0) NQ[tb * 32 + r] = p; }
    const int t = tb * 32 + r;
#pragma unroll
    for (int jb = 0; jb < 2; ++jb) { const int sb = 2 * sub + jb;
        if (sb <= tb) { f32x16 acc = zero16();
#pragma unroll
            for (int ks = 0; ks < 16; ++ks) { const bf16x8 kf = frag_row(KC, 528, sb * 32, ks * 16, lane); acc = mma32(kf, qf[ks], acc); }
            const float mxt = MX[t];
#pragma unroll
            for (int q4 = 0; q4 < 4; ++q4) { const int s0 = sb * 32 + 8 * q4 + 4 * hh; const f32x4 e4 = *(const LAS f32x4*)(E + s0);
                const float w0 = (s0 + 0 <= t) ? __expf(e4[0] - mxt) * 0.0625f : 0.f, w1 = (s0 + 1 <= t) ? __expf(e4[1] - mxt) * 0.0625f : 0.f;
                const float w2 = (s0 + 2 <= t) ? __expf(e4[2] - mxt) * 0.0625f : 0.f, w3 = (s0 + 3 <= t) ? __expf(e4[3] - mxt) * 0.0625f : 0.f;
                u32x2 o; o.x = cvt_pk_bf16(acc[4 * q4 + 0] * w0, acc[4 * q4 + 1] * w1); o.y = cvt_pk_bf16(acc[4 * q4 + 2] * w2, acc[4 * q4 + 3] * w3);
                *(LAS u32x2*)(SS + t * 272 + s0 * 2) = o; } } }
    __syncthreads();
    f32x16 hval[2][2];
#pragma unroll
    for (int hv = 0; hv < 2; ++hv) {
        if (hv) __syncthreads();
        MO_STORE();
        u32x2 og[2][4];
#pragma unroll
        for (int jb = 0; jb < 2; ++jb)
#pragma unroll
            for (int q4 = 0; q4 < 4; ++q4) og[jb][q4] = *(const u32x2*)(P + (size_t)(r0 + t) * NB + 3072 + h * 256 + hv * 128 + (2 * sub + jb) * 32 + 4 * hh + 8 * q4);
        if (hv == 0) MO_LOAD(1);
        if (hv == 0) { const int tt = tid >> 2, part = tid & 3; float sum = 0.f;
            if (part <= (tt >> 5)) {
#pragma unroll
                for (int j = 0; j < 4; ++j) { const u32x4 w = *(const LAS u32x4*)(SS + tt * 272 + part * 64 + j * 16);
                    sum += (bflo(w.x) + bfhi(w.x)) + (bflo(w.y) + bfhi(w.y)) + (bflo(w.z) + bfhi(w.z)) + (bflo(w.w) + bfhi(w.w)); } }
            sum += __shfl_xor(sum, 1); sum += __shfl_xor(sum, 2);
            if (part == 0) { const float wi = __expf(m_c - MX[tt]); const float den = wi * NQ[tt] + sum; const float mt = BT[tt] + MX[tt];
                INV[tt] = 1.0f / fmaxf(fabsf(den), __expf(-mt)); WI[tt] = wi; } }
        __syncthreads();
        const float wi = WI[t], inv = INV[t];
#pragma unroll
        for (int jb = 0; jb < 2; ++jb) { const int vb = 2 * sub + jb; f32x16 acc = zero16();
#pragma unroll
            for (int ks = 0; ks < 16; ++ks) { const bf16x8 cf = frag_row(KC, 528, vb * 32, ks * 16, lane); acc = mma32(cf, qf[ks], acc); }
#pragma unroll
            for (int reg = 0; reg < 16; ++reg) acc[reg] *= wi;
            for (int ks = 0; ks < 2 * (tb + 1); ++ks) { const bf16x8 sf = frag_row(SS, 272, tb * 32, ks * 16, lane); const bf16x8 vf = frag_tr(VV, 272, ks * 16, vb * 32, lane); acc = mma32(vf, sf, acc); }
#pragma unroll
            for (int q4 = 0; q4 < 4; ++q4) { const u32x2 raw = og[jb][q4];
                acc[4 * q4 + 0] *= inv * sigmoidf_(bflo(raw.x)); acc[4 * q4 + 1] *= inv * sigmoidf_(bfhi(raw.x));
                acc[4 * q4 + 2] *= inv * sigmoidf_(bflo(raw.y)); acc[4 * q4 + 3] *= inv * sigmoidf_(bfhi(raw.y)); }
            hval[hv][jb] = acc; }
    }
#undef MO_LOAD
#undef MO_STORE
    const bf16_t* zrow = P + (size_t)(r0 + t) * NB + 4096 + h * 256 + 4 * hh;
    u32x2 zr[2][2][4];
#pragma unroll
    for (int hv = 0; hv < 2; ++hv)
#pragma unroll
        for (int jb = 0; jb < 2; ++jb)
#pragma unroll
            for (int q4 = 0; q4 < 4; ++q4) zr[hv][jb][q4] = *(const u32x2*)(zrow + hv * 128 + (2 * sub + jb) * 32 + 8 * q4);
    { float s2 = 0.f;
#pragma unroll
      for (int reg = 0; reg < 16; ++reg) s2 += (hval[0][0][reg] * hval[0][0][reg] + hval[0][1][reg] * hval[0][1][reg]) + (hval[1][0][reg] * hval[1][0][reg] + hval[1][1][reg] * hval[1][1][reg]);
      s2 += __shfl_xor(s2, 32);
      if (hh == 0) SSQ[sub * 128 + t] = s2; }
    __syncthreads();
    { const float rstd = rsqrtf((SSQ[t] + SSQ[128 + t]) * (1.0f / 256.0f) + EPS);
      const float* gm = a.in[13] + l * 1024 + h * 256 + 4 * hh;
      bf16_t* arow = ACT + (size_t)(r0 + t) * D + h * 256 + 4 * hh;
#pragma unroll
      for (int hv = 0; hv < 2; ++hv)
#pragma unroll
        for (int jb = 0; jb < 2; ++jb)
#pragma unroll
            for (int q4 = 0; q4 < 4; ++q4) { const int cb = hv * 128 + (2 * sub + jb) * 32 + 8 * q4;
                const u32x2 z2 = zr[hv][jb][q4]; const f32x4 g4 = *(const f32x4*)(gm + cb);
                u32x2 o; o.x = cvt_pk_bf16(hval[hv][jb][4 * q4 + 0] * rstd * g4[0] * siluf_(bflo(z2.x)), hval[hv][jb][4 * q4 + 1] * rstd * g4[1] * siluf_(bfhi(z2.x)));
                o.y = cvt_pk_bf16(hval[hv][jb][4 * q4 + 2] * rstd * g4[2] * siluf_(bflo(z2.y)), hval[hv][jb][4 * q4 + 3] * rstd * g4[3] * siluf_(bfhi(z2.y)));
                *(u32x2*)(arow + cb) = o; } }
    __syncthreads();
}

__device__ __forceinline__ void phase_final(const Args& a, int tid, int lane, int wave, int G, int bid) {
    const float* gf = a.in[18];
    for (int r = bid * 8 + wave; r < MT; r += G * 8) {
        float* xr = a.out + OY + (size_t)r * D + lane * 4;
        f32x4 v[8]; float ss = 0.f;
#pragma unroll
        for (int i = 0; i < 8; ++i) { v[i] = *(const f32x4*)(xr + 256 * i); ss += (v[i][0] * v[i][0] + v[i][1] * v[i][1]) + (v[i][2] * v[i][2] + v[i][3] * v[i][3]); }
        const float rstd = rsqrtf(wave_sum(ss) * (1.0f / D) + EPS);
#pragma unroll
        for (int i = 0; i < 8; ++i) { const f32x4 g = *(const f32x4*)(gf + lane * 4 + 256 * i); *(f32x4*)(xr + 256 * i) = v[i] * rstd * g; }
    }
}

__global__ void __launch_bounds__(512, 2) fwd_megakernel(Args a) {
    extern __shared__ __attribute__((aligned(16))) unsigned char lds_raw[];
    LAS unsigned char* lds = (LAS unsigned char*)lds_raw;
    cg::grid_group grid = cg::this_grid();
    const int G = gridDim.x, bid = blockIdx.x;
    const int lo = a.ph_lo, hi = a.ph_hi;
    if (hi > NPHASE) grid.sync();
    if (threadIdx.x < 4) ((LAS unsigned*)(lds + LDS_BYTES - 16))[threadIdx.x] = 0u;
    __syncthreads();
    const XcdBarrier xbar = xcd_barrier_post((unsigned*)a.ws, (volatile LAS unsigned*)(lds + LDS_BYTES - 16));
#define IN(k) (lo <= (k) && (k) < hi)
#define SEAM(k) do { if (IN(k) && IN((k) + 1)) { xcd_barrier(xbar); if (PROBE == 20) xcd_barrier(xbar); } } while (0)
#define TIDS int tid = threadIdx.x; asm volatile("" : "+v"(tid)); const int lane = tid & 63, wave = __builtin_amdgcn_readfirstlane(tid >> 6);
#define REPEAT(n) for (int rep_ = 0; rep_ < ((PROBE == (n)) ? 2 : 1); ++rep_)
#define RSYNC(n) do { if (PROBE == (n) && rep_ == 0) xcd_barrier(xbar); } while (0)
    REPEAT(1) { if (IN(0)) { TIDS phase0(a, lds, tid, lane, wave, G, bid); } RSYNC(1); }
    SEAM(0);
    REPEAT(2) { if (IN(1)) { TIDS phase_ada(a, lds, tid, lane, wave, G, bid); } RSYNC(2); }
    SEAM(1);
#pragma unroll 1
    for (int l = 0; l < 2; ++l) {
        const int pb = 2 + 5 * l;
        REPEAT(3) { if (IN(pb)) { TIDS phase_norm(a, l, lds, tid, lane, wave, G, bid); } RSYNC(3); }
        SEAM(pb);
        REPEAT(4) { if (IN(pb + 1)) {
            pg8::Gemm g{(const bf16_t*)(a.ws + WS_HN), (const bf16_t*)(a.ws + WS_WIN) + (size_t)l * NB * D, MP, NB, D};
            pg8::StaticOrder S; S.init(MP, NB, G, bid);
            pg8::EpiP E{(bf16_t*)(a.ws + WS_P), NB};
            pg8::gemm_phase<pg8::EpiP, pg8::StaticOrder>(lds, g, S, E);
#pragma unroll 1
            for (int item = bid; item < 256; item += G) { TIDS skinny_item<0>(a, l, item * 32, (const bf16_t*)(a.ws + WS_HN) + (size_t)MP * D, (const bf16_t*)(a.ws + WS_WIN) + (size_t)l * NB * D, lds, tid, lane, wave); }
        } RSYNC(4); }
        SEAM(pb + 1);
        REPEAT(5) { if (IN(pb + 2)) {
            unsigned* qctr = (unsigned*)a.ws + 3584 + (l * 2 + rep_) * 64;
            volatile LAS unsigned* qw = (volatile LAS unsigned*)(lds + LDS_BYTES - 32);
#pragma unroll 1
            for (;;) { TIDS
                if (tid == 0) qw[0] = __hip_atomic_fetch_add(qctr, 1u, __ATOMIC_RELAXED, __HIP_MEMORY_SCOPE_AGENT);
                __syncthreads();
                const int item = (int)qw[0];
                __syncthreads();
                if (item >= 896) break;
                if (item < 128) { scan_item(a, l, item, lds, tid, lane, wave); if (PROBE == 8) scan_item(a, l, item, lds, tid, lane, wave); }
                else if (item < 384) { mix_item(a, l, item - 128, lds, tid, lane, wave); if (PROBE == 9) mix_item(a, l, item - 128, lds, tid, lane, wave); }
                else { sample_item(a, l, item - 384, lds, tid, lane, wave); if (PROBE == 10) sample_item(a, l, item - 384, lds, tid, lane, wave); }
            }
        } RSYNC(5); }
        SEAM(pb + 2);
        REPEAT(6) { if (IN(pb + 3)) {
#pragma unroll 1
            for (int item = bid; item < 256; item += G) { TIDS mlstm_out_item(a, l, item, lds, tid, lane, wave); }
        } RSYNC(6); }
        SEAM(pb + 3);
        REPEAT(7) { if (IN(pb + 4)) {
            pg8::Gemm g{(const bf16_t*)(a.ws + WS_ACT), (const bf16_t*)(a.ws + WS_WOUT) + (size_t)l * D * D, MP, D, D};
            pg8::StaticOrder S; S.init(MP, D, G, bid);
            pg8::EpiRes E{l == 0 ? a.in[0] : (const float*)(a.ws + WS_X1), l == 0 ? a.in[1] : (const float*)(a.ws + WS_X1) + (size_t)MP * D,
                          l == 0 ? (float*)(a.ws + WS_X1) : a.out + OY, (const float*)(a.ws + WS_MOD) + (size_t)l * NCR * NMOD};
            pg8::gemm_phase<pg8::EpiRes, pg8::StaticOrder>(lds, g, S, E);
#pragma unroll 1
            for (int item = bid; item < 64; item += G) { TIDS skinny_item<1>(a, l, item * 32, (const bf16_t*)(a.ws + WS_ACT) + (size_t)MP * D, (const bf16_t*)(a.ws + WS_WOUT) + (size_t)l * D * D, lds, tid, lane, wave); }
        } RSYNC(7); }
        SEAM(pb + 4);
    }
    if (IN(12)) { TIDS phase_final(a, tid, lane, wave, G, bid); }
#undef TIDS
#undef IN
#undef SEAM
}

#ifndef N_LAUNCH_MODE
#define N_LAUNCH_MODE 1
#endif

extern "C" void kernel_launch(void* const* d_in, const int* in_sizes, int n_in, void* d_out, int out_size, void* d_ws, size_t ws_size, hipStream_t stream) {
    static int grid = 0;
    if (grid == 0) {
        int dev = 0, cus = 0, per_cu = 0;
        hipGetDevice(&dev);
        hipDeviceGetAttribute(&cus, hipDeviceAttributeMultiprocessorCount, dev);
        hipFuncSetAttribute((const void*)fwd_megakernel, hipFuncAttributeMaxDynamicSharedMemorySize, LDS_BYTES);
        hipOccupancyMaxActiveBlocksPerMultiprocessor(&per_cu, (const void*)fwd_megakernel, 512, LDS_BYTES);
        if (per_cu < 1) { fprintf(stderr, "occupancy query returned %d\n", per_cu); per_cu = 1; }
        grid = cus * per_cu;
        if (n_in != 19 || ws_size < WS_END) { fprintf(stderr, "unexpected n_in %d / ws %zu\n", n_in, ws_size); }
    }
    (void)hipMemsetAsync(d_ws, 0, 16384, stream);
    Args a{};
    for (int i = 0; i < 19; ++i) a.in[i] = (const float*)d_in[i];
    a.out = (float*)d_out; a.ws = (unsigned char*)d_ws;
#if N_LAUNCH_MODE == 1
    a.ph_lo = 0; a.ph_hi = NPHASE;
    void* args[] = {&a};
    hipError_t e = hipLaunchCooperativeKernel((const void*)fwd_megakernel, dim3(grid), dim3(512), args, LDS_BYTES, stream);
    if (e != hipSuccess) fprintf(stderr, "cooperative launch failed: %s (grid %d)\n", hipGetErrorString(e), grid);
#else
    for (int p = 0; p < NPHASE; ++p) {
        a.ph_lo = p; a.ph_hi = p + 1;
        void* args[] = {&a};
        hipError_t e = hipLaunchCooperativeKernel((const void*)fwd_megakernel, dim3(grid), dim3(512), args, LDS_BYTES, stream);
        if (e != hipSuccess) { fprintf(stderr, "launch %d failed: %s (grid %d)\n", p, hipGetErrorString(e), grid); break; }
    }
#endif
}
```

```cpp
#include <hip/hip_runtime.h>
#include <hip/hip_cooperative_groups.h>
#include <cstdio>
namespace cg = cooperative_groups;

#define LAS __attribute__((address_space(3)))
typedef unsigned short bf16_t;
typedef short bf16x8 __attribute__((ext_vector_type(8)));
typedef short s16x4 __attribute__((ext_vector_type(4)));
typedef float f32x4 __attribute__((ext_vector_type(4)));
typedef float f32x16 __attribute__((ext_vector_type(16)));
typedef unsigned u32x4 __attribute__((ext_vector_type(4)));
typedef unsigned u32x2 __attribute__((ext_vector_type(2)));

constexpr int D = 2048, MP = 8192, MS = 128, MT = 8320, MPAD = 8448;
constexpr int NB = 8192, DIN = 8200, NMOD = 6144, NCR = 132;
constexpr float EPS = 1e-6f;
constexpr size_t OY = 0, OCP = 17039360, ONP = 19136512, OMP = 19144704, OCS = 19144736, ONS = 86253600, OMS = 86515744, OVS = 86516768;
constexpr size_t MiB = 1u << 20;
constexpr size_t WS_WIN = 1 * MiB;
constexpr size_t WS_WOUT = 65 * MiB;
constexpr size_t WS_SC = 81 * MiB;
constexpr size_t WS_MOD = 82 * MiB;
constexpr size_t WS_HN = 90 * MiB;
constexpr size_t WS_P = 123 * MiB;
constexpr size_t WS_IG = 255 * MiB;
constexpr size_t WS_LF = 255 * MiB + 512 * 1024;
constexpr size_t WS_X1 = 256 * MiB;
constexpr size_t WS_ACT = 321 * MiB;
constexpr size_t WS_CST = 354 * MiB;
constexpr size_t WS_NST = 386 * MiB;
constexpr size_t WS_MST = 386 * MiB + 512 * 1024;
constexpr size_t WS_END = 387 * MiB;
constexpr int LDS_BYTES = 155648;
constexpr int NPHASE = 13;
#ifndef PROBE
#define PROBE 0
#endif

struct Args { const float* in[19]; float* out; unsigned char* ws; int ph_lo, ph_hi; };

__device__ __forceinline__ float bf2f(bf16_t b) { return __uint_as_float(((unsigned)b) << 16); }
__device__ __forceinline__ float bflo(unsigned w) { return __uint_as_float(w << 16); }
__device__ __forceinline__ float bfhi(unsigned w) { return __uint_as_float(w & 0xffff0000u); }
__device__ __forceinline__ unsigned cvt_pk_bf16(float lo, float hi) { unsigned r; asm volatile("v_cvt_pk_bf16_f32 %0, %1, %2" : "=v"(r) : "v"(lo), "v"(hi)); return r; }
__device__ __forceinline__ bf16_t f2bf(float f) { return (bf16_t)(cvt_pk_bf16(f, 0.f) & 0xffffu); }
__device__ __forceinline__ float sigmoidf_(float x) { return 1.0f / (1.0f + __expf(-x)); }
__device__ __forceinline__ float siluf_(float x) { return x / (1.0f + __expf(-x)); }
__device__ __forceinline__ float geluf_(float x) { const float u = 1.5957691216f * (x + 0.044715f * x * x * x); return x / (1.0f + __expf(-u)); }
__device__ __forceinline__ float wave_sum(float v) {
#pragma unroll
    for (int o = 1; o < 64; o <<= 1) v += __shfl_xor(v, o);
    return v;
}
__device__ __forceinline__ int rowof(int reg, int hh) { return (reg & 3) + 8 * (reg >> 2) + 4 * hh; }
__device__ __forceinline__ bf16x8 frag_row(const LAS unsigned char* base, int ldb, int row0, int k0, int lane) {
    return *(const LAS bf16x8*)(base + (row0 + (lane & 31)) * ldb + (k0 + 8 * (lane >> 5)) * 2);
}
__device__ __forceinline__ bf16x8 frag_tr(const LAS unsigned char* base, int ldb, int k0, int n0, int lane) {
    const int hh = lane >> 5, blk = (lane >> 4) & 1, q = (lane & 15) >> 2, p = lane & 3;
    const LAS unsigned char* a = base + (k0 + 8 * hh + q) * ldb + (n0 + 16 * blk + 4 * p) * 2;
    const s16x4 lo = __builtin_amdgcn_ds_read_tr16_b64_v4i16((LAS s16x4*)a);
    const s16x4 hi = __builtin_amdgcn_ds_read_tr16_b64_v4i16((LAS s16x4*)(a + 4 * ldb));
    return (bf16x8){lo[0], lo[1], lo[2], lo[3], hi[0], hi[1], hi[2], hi[3]};
}
__device__ __forceinline__ f32x16 mma32(bf16x8 a, bf16x8 b, f32x16 c) { return __builtin_amdgcn_mfma_f32_32x32x16_bf16(a, b, c, 0, 0, 0); }
__device__ __forceinline__ f32x16 zero16() { f32x16 z;
#pragma unroll
    for (int i = 0; i < 16; ++i) z[i] = 0.f;
    return z; }

#define XB_TMO      128
#define XB_XCNT(j)  (256  + 64 * (j))
#define XB_XSUB(j)  (1280 + 64 * (j))
#define XB_XGEN(j)  (2304 + 64 * (j))
#define XB_TOP      3328
#define XB_TOPGEN   3392
#define XCD_BAR_WORDS 3456
#define XB_SPIN_CAP (1u << 18)
__device__ __forceinline__ unsigned xb_ld(unsigned* p)              { return __hip_atomic_load(p, __ATOMIC_RELAXED, __HIP_MEMORY_SCOPE_AGENT); }
__device__ __forceinline__ unsigned xb_add(unsigned* p, unsigned v) { return __hip_atomic_fetch_add(p, v, __ATOMIC_RELAXED, __HIP_MEMORY_SCOPE_AGENT); }
__device__ __forceinline__ unsigned xb_xcc_id() { return (unsigned)__builtin_amdgcn_s_getreg((3 << 11) | 20) & 0xFu; }
#define XB_SPIN(cond, bar) do { unsigned _sp = 0; while (cond) { __builtin_amdgcn_s_sleep(1); \
    if ((++_sp & 255u) == 0u) { if (xb_ld(&(bar)[XB_TMO])) break; if (_sp > XB_SPIN_CAP) { atomicAdd(&(bar)[XB_TMO], 1u); break; } } } } while (0)
struct XcdBarrier { unsigned* bar; unsigned x; volatile LAS unsigned* st; };
__device__ __forceinline__ XcdBarrier xcd_barrier_post(unsigned* bar, volatile LAS unsigned* st) {
    XcdBarrier b; b.bar = bar; b.x = xb_xcc_id(); b.st = st;
    if (threadIdx.x == 0) (void)xb_add(&bar[XB_XCNT(b.x)], 1u);
    return b;
}
__device__ __forceinline__ void xcd_barrier_complete(unsigned* bar, unsigned x, unsigned& nloc, unsigned& nx) {
    const unsigned G = gridDim.x * gridDim.y * gridDim.z;
    unsigned sum, cnt, mine, sp = 0u;
    for (;;) {
        sum = 0u; cnt = 0u; mine = 0u;
#pragma unroll
        for (unsigned j = 0; j < 16; ++j) { const unsigned c = xb_ld(&bar[XB_XCNT(j)]); sum += c; cnt += (c > 0u) ? 1u : 0u; mine = (j == x) ? c : mine; }
        if (sum == G) break;
        __builtin_amdgcn_s_sleep(1);
        if ((++sp & 255u) == 0u) { if (xb_ld(&bar[XB_TMO])) break; if (sp > XB_SPIN_CAP) { atomicAdd(&bar[XB_TMO], 1u); break; } }
    }
    nloc = mine > 0u ? mine : 1u; nx = cnt > 0u ? cnt : 1u;
}
__device__ __forceinline__ void xcd_barrier(const XcdBarrier& b) {
    asm volatile("s_waitcnt vmcnt(0)" ::: "memory");
    __syncthreads();
    if (threadIdx.x == 0) {
        unsigned* bar = b.bar;
        __builtin_amdgcn_s_waitcnt(0);
        unsigned nloc = b.st[0], nx = b.st[1];
        if (nloc == 0u) { xcd_barrier_complete(bar, b.x, nloc, nx); b.st[0] = nloc; b.st[1] = nx; }
        const unsigned old = xb_add(&bar[XB_XSUB(b.x)], 1u);
        const unsigned gen = old / nloc;
        if (old + 1u == (gen + 1u) * nloc) {
            __builtin_amdgcn_fence(__ATOMIC_RELEASE, "agent");
            asm volatile("s_waitcnt vmcnt(0)" ::: "memory");
            const unsigned og = xb_add(&bar[XB_TOP], 1u);
            const unsigned tg = og / nx;
            if (og + 1u == (tg + 1u) * nx) xb_add(&bar[XB_TOPGEN], 1u);
            else XB_SPIN(xb_ld(&bar[XB_TOPGEN]) == tg, bar);
            __builtin_amdgcn_fence(__ATOMIC_ACQUIRE, "agent");
            xb_add(&bar[XB_XGEN(b.x)], 1u);
            asm volatile("s_waitcnt vmcnt(0)" ::: "memory");
        } else {
            XB_SPIN(xb_ld(&bar[XB_XGEN(b.x)]) == gen, bar);
            __builtin_amdgcn_fence(__ATOMIC_ACQUIRE, "agent");
            asm volatile("s_waitcnt vmcnt(0)" ::: "memory");
        }
    }
    __syncthreads();
}

namespace pg8 {
constexpr int BM = 256, BK = 64, HALF = 128, HTB = HALF * BK * 2, STAGE_BYTES = 8 * HTB, NXCD = 8, WGM = 8;
__device__ __forceinline__ int lds_byte(int r, int c) { const int st = (r >> 4) * 2 + (c >> 5), rr = r & 15, cc = c & 31, ob = rr * 64 + cc * 2; return st * 1024 + (ob ^ (((ob >> 9) & 1) << 5)); }
__device__ __forceinline__ void stage_rc(int b, int& R, int& C) { const int st = b / 1024, sb = b % 1024, swz = sb ^ (((sb >> 9) & 1) << 5); R = (st >> 1) * 16 + swz / 64; C = (st & 1) * 32 + (swz % 64) / 2; }
__device__ __forceinline__ int perm32(int rho) { const int n = rho >> 4, i = rho & 15; return 8 * (i >> 2) + 4 * n + (i & 3); }
struct Unit { int pm, pn; };
struct Gemm { const bf16_t* A; const bf16_t* Bt; int M, N, K; };
struct StaticOrder {
    int nM, nN, nwg, G, c;
    __device__ void init(int M, int N, int G_, int c_) { nM = M / BM; nN = N / BM; nwg = nM * nN; G = G_; c = c_; }
    __device__ bool next(int i, Unit& u) const {
        const long L = (long)i * G + c; if (L >= nwg) return false;
        int wgid = (int)L; { const int q = nwg / NXCD, r = nwg % NXCD, xcd = wgid % NXCD, off = wgid / NXCD; wgid = (xcd < r ? xcd * (q + 1) : r * (q + 1) + (xcd - r) * q) + off; }
        const int nig = WGM * nN, gid = wgid / nig, fm = gid * WGM, gsz = (nM - fm) < WGM ? (nM - fm) : WGM;
        u.pm = fm + ((wgid % nig) % gsz); u.pn = (wgid % nig) / gsz; return true;
    }
};
struct EpiP {
    static constexpr bool PERM = true;
    bf16_t* O; int ldc;
    __device__ __forceinline__ void operator()(const f32x4 (&acc)[2][2][4][2], const Unit& u, int wr, int wc, int fr, int fq) const {
        const int row0 = u.pm * BM + wr * 64 + fr, col0 = u.pn * BM + wc * 32 + 8 * fq;
#pragma unroll
        for (int ai = 0; ai < 2; ++ai)
#pragma unroll
            for (int m = 0; m < 4; ++m) { bf16_t* rowp = O + (size_t)(row0 + ai * HALF + m * 16) * ldc + col0;
#pragma unroll
                for (int bj = 0; bj < 2; ++bj) { const f32x4 v0 = acc[ai][bj][m][0], v1 = acc[ai][bj][m][1];
                    u32x4 w; w.x = cvt_pk_bf16(v0[0], v0[1]); w.y = cvt_pk_bf16(v0[2], v0[3]); w.z = cvt_pk_bf16(v1[0], v1[1]); w.w = cvt_pk_bf16(v1[2], v1[3]);
                    *(u32x4*)(rowp + bj * HALF) = w; } }
    }
};
struct EpiRes {
    static constexpr bool PERM = false;
    const float* xp; const float* xs; float* dst; const float* mod;
    __device__ __forceinline__ void operator()(const f32x4 (&acc)[2][2][4][2], const Unit& u, int wr, int wc, int fr, int fq) const {
        const int row0 = u.pm * BM + wr * 64 + fr, col0 = u.pn * BM + wc * 32 + 4 * fq;
#pragma unroll
        for (int ai = 0; ai < 2; ++ai)
#pragma unroll
            for (int m = 0; m < 4; ++m) { const int r = row0 + ai * HALF + m * 16;
                if (r < MT) {
                    const int mrow = r < MP ? (r >> 11) : 4 + (r - MP);
                    const float* xo = (r < MP ? xp + (size_t)r * D : xs + (size_t)(r - MP) * D) + col0;
                    const float* gp = mod + (size_t)mrow * NMOD + 4096 + col0;
                    float* dp = dst + (size_t)r * D + col0;
#pragma unroll
                    for (int bj = 0; bj < 2; ++bj)
#pragma unroll
                        for (int n = 0; n < 2; ++n) { const f32x4 g = *(const f32x4*)(gp + bj * HALF + n * 16); const f32x4 x = *(const f32x4*)(xo + bj * HALF + n * 16);
                            *(f32x4*)(dp + bj * HALF + n * 16) = x + g * acc[ai][bj][m][n]; } } }
    }
};

template <class Epi, class Sched>
__device__ __forceinline__ void gemm_phase(LAS unsigned char* lds, const Gemm g, const Sched& S, const Epi& E) {
    int tid = threadIdx.x; asm volatile("" : "+v"(tid));
    const int wid = __builtin_amdgcn_readfirstlane(tid >> 6), lane = tid & 63, wr = wid >> 2, wc = wid & 3, fr = lane & 15, fq = lane >> 4;
    const int K = g.K, nt = K / BK;
    unsigned voffA[2], voffB[2];
#pragma unroll
    for (int i = 0; i < 2; ++i) { int R, C; stage_rc(tid * 16 + i * 8192, R, C); const int Rb = Epi::PERM ? ((R & ~31) + perm32(R & 31)) : R;
        voffA[i] = (unsigned)(R * K + C) * 2u; voffB[i] = (unsigned)(Rb * K + C) * 2u; }
    const size_t kstep = (size_t)(BK * 2);
    const size_t hstep = (size_t)HALF * K * 2;
    const size_t tstep = 2 * hstep;
    const unsigned ldsw = (unsigned)wid * 1024u;
    const int aoff = lds_byte(wr * 64 + fr, fq * 8), boff = lds_byte(wc * 32 + fr, fq * 8);
#define PG8_SA(b, h) (((b) * 2 + (h)) * HTB)
#define PG8_SB(b, h) ((4 + (b) * 2 + (h)) * HTB)
#define PG8_STAGE(bufoff, gbase, voff) do { _Pragma("unroll") for (int _i = 0; _i < 2; ++_i) \
        __builtin_amdgcn_global_load_lds((const unsigned*)((const char*)(gbase) + (voff)[_i]), (LAS unsigned*)(lds + (bufoff) + ldsw + _i * 8192), 16, 0, 0); } while (0)
#define PG8_LDA(dst, b, h) do { _Pragma("unroll") for (int m = 0; m < 4; ++m) _Pragma("unroll") for (int k = 0; k < 2; ++k) dst[m][k] = *(const LAS bf16x8*)(lds + PG8_SA(b, h) + aoff + m * 2048 + k * 1024); } while (0)
#define PG8_LDB(dst, b, h) do { _Pragma("unroll") for (int n = 0; n < 2; ++n) _Pragma("unroll") for (int k = 0; k < 2; ++k) dst[n][k] = *(const LAS bf16x8*)(lds + PG8_SB(b, h) + boff + n * 2048 + k * 1024); } while (0)
#define PG8_MMA(ai, bj, At, Bt) do { __builtin_amdgcn_s_setprio(1); _Pragma("unroll") for (int m = 0; m < 4; ++m) _Pragma("unroll") for (int n = 0; n < 2; ++n) _Pragma("unroll") for (int k = 0; k < 2; ++k) \
        acc[ai][bj][m][n] = __builtin_amdgcn_mfma_f32_16x16x32_bf16(Bt[n][k], At[m][k], acc[ai][bj][m][n], 0, 0, 0); __builtin_amdgcn_s_setprio(0); } while (0)
#define PG8_WAIT_V(n) asm volatile("s_waitcnt vmcnt(" #n ")" ::: "memory")
#define PG8_WAIT_L(n) asm volatile("s_waitcnt lgkmcnt(" #n ")" ::: "memory")
#define PG8_BAR __builtin_amdgcn_s_barrier()
#define PG8_SCHED __builtin_amdgcn_sched_barrier(0)
    Unit cur, nxt; int ui = 0;
    if (!S.next(0, cur)) return;
    f32x4 acc[2][2][4][2];
#pragma unroll
    for (int a = 0; a < 2; ++a)
#pragma unroll
        for (int b = 0; b < 2; ++b)
#pragma unroll
            for (int m = 0; m < 4; ++m)
#pragma unroll
                for (int n = 0; n < 2; ++n) acc[a][b][m][n] = (f32x4){0.f, 0.f, 0.f, 0.f};
    bf16x8 At[4][2], B0[2][2], B1[2][2];
    const char* cA = (const char*)g.A + (size_t)cur.pm * tstep; const char* cB = (const char*)g.Bt + (size_t)cur.pn * tstep;
    PG8_STAGE(PG8_SB(0, 0), cB, voffB); PG8_STAGE(PG8_SA(0, 0), cA, voffA); PG8_STAGE(PG8_SB(0, 1), cB + hstep, voffB); PG8_STAGE(PG8_SA(0, 1), cA + hstep, voffA);
    if (wr == 1) PG8_BAR;
    PG8_WAIT_V(4); PG8_BAR;
    PG8_STAGE(PG8_SB(1, 0), cB + kstep, voffB); PG8_STAGE(PG8_SA(1, 0), cA + kstep, voffA); PG8_STAGE(PG8_SB(1, 1), cB + hstep + kstep, voffB);
    PG8_WAIT_V(6); PG8_BAR;
    for (;;) {
        const bool has_next = S.next(ui + 1, nxt);
        const char* nA = has_next ? (const char*)g.A + (size_t)nxt.pm * tstep : cA; const char* nB = has_next ? (const char*)g.Bt + (size_t)nxt.pn * tstep : cB;
        for (int t = 0; t < nt; t += 2) {
            const bool last = (t == nt - 2);
            const char* a1 = cA + (size_t)(t + 1) * kstep;
            const char* a2 = last ? nA : cA + (size_t)(t + 2) * kstep; const char* b2 = last ? nB : cB + (size_t)(t + 2) * kstep;
            const char* a3 = a2 + kstep; const char* b3 = b2 + kstep;
            PG8_LDB(B0, 0, 0); PG8_SCHED; PG8_LDA(At, 0, 0); PG8_STAGE(PG8_SA(1, 1), a1 + hstep, voffA);
            PG8_WAIT_L(8); PG8_BAR; PG8_WAIT_L(0); PG8_MMA(0, 0, At, B0); PG8_BAR; PG8_SCHED;
            PG8_LDB(B1, 0, 1); PG8_STAGE(PG8_SB(0, 0), b2, voffB);
            PG8_BAR; PG8_WAIT_L(0); PG8_MMA(0, 1, At, B1); PG8_BAR;
            PG8_LDA(At, 0, 1); PG8_STAGE(PG8_SA(0, 0), a2, voffA);
            PG8_BAR; PG8_WAIT_L(0); PG8_MMA(1, 0, At, B0); PG8_BAR; PG8_SCHED;
            PG8_STAGE(PG8_SB(0, 1), b2 + hstep, voffB);
            PG8_WAIT_V(6); PG8_BAR; PG8_MMA(1, 1, At, B1); PG8_BAR;
            PG8_LDB(B0, 1, 0); PG8_SCHED; PG8_LDA(At, 1, 0); PG8_STAGE(PG8_SA(0, 1), a2 + hstep, voffA);
            PG8_WAIT_L(8); PG8_BAR; PG8_WAIT_L(0); PG8_MMA(0, 0, At, B0); PG8_BAR; PG8_SCHED;
            PG8_LDB(B1, 1, 1); PG8_STAGE(PG8_SB(1, 0), b3, voffB);
            PG8_BAR; PG8_WAIT_L(0); PG8_MMA(0, 1, At, B1); PG8_BAR;
            PG8_LDA(At, 1, 1); PG8_STAGE(PG8_SA(1, 0), a3, voffA);
            PG8_BAR; PG8_WAIT_L(0); PG8_MMA(1, 0, At, B0); PG8_BAR; PG8_SCHED;
            PG8_STAGE(PG8_SB(1, 1), b3 + hstep, voffB);
            PG8_WAIT_V(6); PG8_BAR; PG8_MMA(1, 1, At, B1); PG8_BAR;
        }
        E(acc, cur, wr, wc, fr, fq);
        if (!has_next) break;
#pragma unroll
        for (int a = 0; a < 2; ++a)
#pragma unroll
            for (int b = 0; b < 2; ++b)
#pragma unroll
                for (int m = 0; m < 4; ++m)
#pragma unroll
                    for (int n = 0; n < 2; ++n) acc[a][b][m][n] = (f32x4){0.f, 0.f, 0.f, 0.f};
        cur = nxt; cA = nA; cB = nB; ++ui;
    }
    PG8_WAIT_V(0);
    if (wr == 0) PG8_BAR;
    PG8_BAR;
#undef PG8_SA
#undef PG8_SB
#undef PG8_STAGE
#undef PG8_LDA
#undef PG8_LDB
#undef PG8_MMA
#undef PG8_WAIT_V
#undef PG8_WAIT_L
#undef PG8_BAR
#undef PG8_SCHED
}
}

template <int MODE>
__device__ __forceinline__ void skinny_item(const Args& a, int l, int n0, const bf16_t* Arows, const bf16_t* Bt, LAS unsigned char* lds, int tid, int lane, int wave) {
    LAS float* red = (LAS float*)lds;
    const int r = lane & 31, hh = lane >> 5;
    f32x16 acc[4];
#pragma unroll
    for (int i = 0; i < 4; ++i) acc[i] = zero16();
    const bf16_t* bp = Bt + (size_t)(n0 + r) * D + wave * 256 + 8 * hh;
    const bf16_t* ap = Arows + (size_t)r * D + wave * 256 + 8 * hh;
#pragma unroll 8
    for (int ks = 0; ks < 16; ++ks) { const bf16x8 bf = *(const bf16x8*)(bp + ks * 16);
#pragma unroll
        for (int rb = 0; rb < 4; ++rb) { const bf16x8 af = *(const bf16x8*)(ap + (size_t)rb * 32 * D + ks * 16); acc[rb] = mma32(bf, af, acc[rb]); } }
#pragma unroll
    for (int rb = 0; rb < 4; ++rb)
#pragma unroll
        for (int reg = 0; reg < 16; ++reg) red[((wave * 4 + rb) * 16 + reg) * 64 + lane] = acc[rb][reg];
    __syncthreads();
#pragma unroll
    for (int i = 0; i < 8; ++i) { const int e = tid + 512 * i; float sum = 0.f;
#pragma unroll
        for (int w = 0; w < 8; ++w) sum += red[w * 4096 + e];
        const int rb = e >> 10, reg = (e >> 6) & 15, ln = e & 63; const int m = rb * 32 + (ln & 31), n = n0 + rowof(reg, ln >> 5);
        if (MODE == 0) ((bf16_t*)(a.ws + WS_P))[(size_t)(MP + m) * NB + n] = f2bf(sum);
        else { const float* xs = l == 0 ? a.in[1] : (const float*)(a.ws + WS_X1) + (size_t)MP * D; float* dst = (l == 0 ? (float*)(a.ws + WS_X1) : a.out + OY) + (size_t)MP * D;
            const float gate = ((const float*)(a.ws + WS_MOD))[((size_t)l * NCR + 4 + m) * NMOD + 4096 + n];
            dst[(size_t)m * D + n] = xs[(size_t)m * D + n] + gate * sum; } }
    __syncthreads();
}

__device__ __forceinline__ void transpose_item(const float* W, int ldw, int nblk, bf16_t* WT, int K, int item, bool remap, LAS float* scr, int lane) {
    const int kb = item / nblk, nb = item % nblk, k0 = 64 * kb, n0 = 32 * nb;
    const int n0s = (remap && n0 >= 5120) ? n0 + 8 : n0;
#pragma unroll 8
    for (int i = 0; i < 32; ++i) { const int kk = 2 * i + (lane >> 5); scr[kk * 33 + (lane & 31)] = W[(size_t)(k0 + kk) * ldw + n0s + (lane & 31)]; }
    asm volatile("s_waitcnt lgkmcnt(0)" ::: "memory");
    const int c = lane & 7;
#pragma unroll
    for (int j = 0; j < 4; ++j) { const int n = (lane >> 3) + 8 * j; const LAS float* s = scr + (8 * c) * 33 + n;
        u32x4 o; o.x = cvt_pk_bf16(s[0 * 33], s[1 * 33]); o.y = cvt_pk_bf16(s[2 * 33], s[3 * 33]); o.z = cvt_pk_bf16(s[4 * 33], s[5 * 33]); o.w = cvt_pk_bf16(s[6 * 33], s[7 * 33]);
        *(u32x4*)(WT + (size_t)(n0 + n) * K + k0 + 8 * c) = o; }
    asm volatile("s_waitcnt lgkmcnt(0)" ::: "memory");
}
__device__ __forceinline__ void phase0(const Args& a, LAS unsigned char* lds, int tid, int lane, int wave, int G, int bid) {
    bf16_t* SC = (bf16_t*)(a.ws + WS_SC);
    const float* cp = a.in[5]; const float* cs = a.in[6];
    for (int i = bid * 512 + tid; i < 160 * 512; i += G * 512) {
        const int r = i >> 9, c4 = (i & 511) * 4;
        f32x4 v = (f32x4){0.f, 0.f, 0.f, 0.f};
        if (r < 4) v = *(const f32x4*)(cp + (size_t)r * D + c4); else if (r < NCR) v = *(const f32x4*)(cs + (size_t)(r - 4) * D + c4);
        u32x2 o; o.x = cvt_pk_bf16(siluf_(v[0]), siluf_(v[1])); o.y = cvt_pk_bf16(siluf_(v[2]), siluf_(v[3]));
        *(u32x2*)(SC + (size_t)r * D + c4) = o;
    }
}
__device__ __forceinline__ void transpose_wg_item(const Args& a, LAS unsigned char* lds, int wgitem, int lane, int wave) {
    LAS float* scr = (LAS float*)(lds + wave * 8448);
    constexpr int I_IN = 32 * 256, I_OUT = 32 * 64;
    const int it = wgitem * 8 + wave;
    if (it < 2 * I_IN) { const int l = it / I_IN, r = it % I_IN;
        transpose_item(a.in[10] + (size_t)l * D * DIN, DIN, 256, (bf16_t*)(a.ws + WS_WIN) + (size_t)l * NB * D, D, r, true, scr, lane); }
    else if (it < 2 * I_IN + 2 * I_OUT) { const int j = it - 2 * I_IN, l = j / I_OUT, r = j % I_OUT;
        transpose_item(a.in[17] + (size_t)l * D * D, D, 64, (bf16_t*)(a.ws + WS_WOUT) + (size_t)l * D * D, D, r, false, scr, lane); }
}

__device__ __forceinline__ void ada_item(const Args& a, LAS unsigned char* lds, int item, int tid, int lane, int wave) {
    const bf16_t* SC = (const bf16_t*)(a.ws + WS_SC);
    float* MOD = (float*)(a.ws + WS_MOD);
    LAS float* red = (LAS float*)lds;
    const int r = lane & 31, hh = lane >> 5;
    {
        const int l = item / 192, n0 = (item % 192) * 32;
        const float* W = a.in[8] + (size_t)l * D * NMOD;
        const int kbase = wave * 256;
        f32x16 acc[5];
#pragma unroll
        for (int i = 0; i < 5; ++i) acc[i] = zero16();
#pragma unroll 4
        for (int ks = 0; ks < 16; ++ks) {
            const int k0 = kbase + ks * 16;
            const float* wp = W + (size_t)(k0 + 8 * hh) * NMOD + n0 + r;
            float wv[8];
#pragma unroll
            for (int j = 0; j < 8; ++j) wv[j] = wp[(size_t)j * NMOD];
            union { u32x4 u; bf16x8 v; } bfr;
            bfr.u.x = cvt_pk_bf16(wv[0], wv[1]); bfr.u.y = cvt_pk_bf16(wv[2], wv[3]); bfr.u.z = cvt_pk_bf16(wv[4], wv[5]); bfr.u.w = cvt_pk_bf16(wv[6], wv[7]);
#pragma unroll
            for (int rb = 0; rb < 5; ++rb) { const bf16x8 af = *(const bf16x8*)(SC + (size_t)(rb * 32 + r) * D + k0 + 8 * hh); acc[rb] = mma32(af, bfr.v, acc[rb]); }
        }
#pragma unroll
        for (int rb = 0; rb < 5; ++rb) {
#pragma unroll
            for (int reg = 0; reg < 16; ++reg) red[wave * 1024 + reg * 64 + lane] = acc[rb][reg];
            __syncthreads();
#pragma unroll
            for (int e2 = 0; e2 < 2; ++e2) { const int e = tid + e2 * 512; float s = 0.f;
#pragma unroll
                for (int w = 0; w < 8; ++w) s += red[w * 1024 + e];
                const int reg = e >> 6, ln = e & 63; const int row = rb * 32 + rowof(reg, ln >> 5), col = n0 + (ln & 31);
                if (row < NCR) MOD[((size_t)l * NCR + row) * NMOD + col] = s + a.in[9][(size_t)l * NMOD + col]; }
            __syncthreads();
        }
    }
}

__device__ __forceinline__ void phase_norm(const Args& a, int l, LAS unsigned char* lds, int tid, int lane, int wave, int G, int bid) {
    LAS float* Wg = (LAS float*)lds;
    const float* win = a.in[10] + (size_t)l * D * DIN;
    for (int k = tid; k < D; k += 512) { const f32x4 w0 = *(const f32x4*)(win + (size_t)k * DIN + 5120), w1 = *(const f32x4*)(win + (size_t)k * DIN + 5124);
        Wg[0 * D + k] = w0[0]; Wg[1 * D + k] = w0[1]; Wg[2 * D + k] = w0[2]; Wg[3 * D + k] = w0[3];
        Wg[4 * D + k] = w1[0]; Wg[5 * D + k] = w1[1]; Wg[6 * D + k] = w1[2]; Wg[7 * D + k] = w1[3]; }
    __syncthreads();
    const float* xp = l == 0 ? a.in[0] : (const float*)(a.ws + WS_X1);
    const float* xs = l == 0 ? a.in[1] : (const float*)(a.ws + WS_X1) + (size_t)MP * D;
    const float* gn = a.in[7] + (size_t)l * D;
    const float* MOD = (const float*)(a.ws + WS_MOD) + (size_t)l * NCR * NMOD;
    bf16_t* HN = (bf16_t*)(a.ws + WS_HN);
    float* IG = (float*)(a.ws + WS_IG); float* LF = (float*)(a.ws + WS_LF);
    f32x4 v[8];
    { const int r = bid * 8 + wave;
      if (r < MT) { const float* xr = (r < MP ? xp + (size_t)r * D : xs + (size_t)(r - MP) * D) + lane * 4;
#pragma unroll
          for (int i = 0; i < 8; ++i) v[i] = *(const f32x4*)(xr + 256 * i); } }
#pragma unroll 1
    for (int r = bid * 8 + wave; r < MT; r += G * 8) {
        const int rn = r + G * 8;
        f32x4 vn[8];
        if (rn < MT) { const float* xr = (rn < MP ? xp + (size_t)rn * D : xs + (size_t)(rn - MP) * D) + lane * 4;
#pragma unroll
            for (int i = 0; i < 8; ++i) vn[i] = *(const f32x4*)(xr + 256 * i); }
        const int mrow = r < MP ? (r >> 11) : 4 + (r - MP);
        const float* mp = MOD + (size_t)mrow * NMOD + lane * 4;
        float ss = 0.f;
#pragma unroll
        for (int i = 0; i < 8; ++i) ss += (v[i][0] * v[i][0] + v[i][1] * v[i][1]) + (v[i][2] * v[i][2] + v[i][3] * v[i][3]);
        const float rstd = rsqrtf(wave_sum(ss) * (1.0f / D) + EPS);
        float gd[8];
#pragma unroll
        for (int j = 0; j < 8; ++j) gd[j] = 0.f;
#pragma unroll
        for (int i = 0; i < 8; ++i) {
            const f32x4 g = *(const f32x4*)(gn + lane * 4 + 256 * i), sh = *(const f32x4*)(mp + 256 * i), sc = *(const f32x4*)(mp + 2048 + 256 * i);
            const f32x4 hv = v[i] * rstd * g * (sc + 1.0f) + sh;
            u32x2 o; o.x = cvt_pk_bf16(hv[0], hv[1]); o.y = cvt_pk_bf16(hv[2], hv[3]);
            *(u32x2*)(HN + (size_t)r * D + lane * 4 + 256 * i) = o;
#pragma unroll
            for (int j = 0; j < 8; ++j) { const f32x4 w = *(const LAS f32x4*)(Wg + j * D + lane * 4 + 256 * i); gd[j] += (hv[0] * w[0] + hv[1] * w[1]) + (hv[2] * w[2] + hv[3] * w[3]); }
        }
#pragma unroll
        for (int j = 0; j < 8; ++j) gd[j] = wave_sum(gd[j]);
        if (lane < 4) {
            const float gi = lane == 0 ? gd[0] : lane == 1 ? gd[1] : lane == 2 ? gd[2] : gd[3];
            const float gf = lane == 0 ? gd[4] : lane == 1 ? gd[5] : lane == 2 ? gd[6] : gd[7];
            IG[r * 4 + lane] = gi + a.in[11][l * 4 + lane];
            const float f = gf + a.in[12][l * 4 + lane];
            LF[r * 4 + lane] = fminf(f, 0.f) - log1pf(expf(-fabsf(f)));
        }
        if (rn < MT) {
#pragma unroll
            for (int i = 0; i < 8; ++i) v[i] = vn[i]; }
    }
    __syncthreads();
}

__device__ __forceinline__ void chunk_scan(const float* IG, const float* LF, int r0, int h, int lane, float& b0, float& b1, float& e0, float& e1, float& cm0, float& cm1) {
    const float lf0 = LF[(r0 + 2 * lane) * 4 + h], lf1 = LF[(r0 + 2 * lane + 1) * 4 + h];
    const float ig0 = IG[(r0 + 2 * lane) * 4 + h], ig1 = IG[(r0 + 2 * lane + 1) * 4 + h];
    float s = lf0 + lf1;
#pragma unroll
    for (int o = 1; o < 64; o <<= 1) { const float t = __shfl_up(s, o); if (lane >= o) s += t; }
    b1 = s; b0 = s - lf1;
    e0 = ig0 - b0; e1 = ig1 - b1;
    float mx = fmaxf(e0, e1);
#pragma unroll
    for (int o = 1; o < 64; o <<= 1) { const float t = __shfl_up(mx, o); if (lane >= o) mx = fmaxf(mx, t); }
    cm1 = mx;
    const float prev = __shfl_up(mx, 1);
    cm0 = lane > 0 ? fmaxf(prev, e0) : e0;
}

__device__ __forceinline__ void scan_item(const Args& a, int l, int item, LAS unsigned char* lds, int tid, int lane, int wave) {
    const int bh = item >> 3, vt = (item >> 2) & 1, dt = item & 3, b = bh >> 2, h = bh & 3;
    LAS unsigned char* Vt = lds;
    LAS unsigned char* Kt = lds + 34816;
    LAS float* E = (LAS float*)(lds + 53248);
    LAS float* Gs = E + 2048;
    LAS float* Bc = Gs + 2048; LAS float* CMX = Bc + 16; LAS float* MC = CMX + 16; LAS float* DEC = MC + 32;
    const float* IG = (const float*)(a.ws + WS_IG); const float* LF = (const float*)(a.ws + WS_LF);
    const bf16_t* P = (const bf16_t*)(a.ws + WS_P);
    bf16_t* CST = (bf16_t*)(a.ws + WS_CST); float* NST = (float*)(a.ws + WS_NST); float* MST = (float*)(a.ws + WS_MST);
#pragma unroll
    for (int j = 0; j < 2; ++j) { const int cc = 2 * wave + j; float b0, b1, e0, e1, cm0, cm1;
        chunk_scan(IG, LF, b * 2048 + cc * 128, h, lane, b0, b1, e0, e1, cm0, cm1);
        E[cc * 128 + 2 * lane] = e0; E[cc * 128 + 2 * lane + 1] = e1;
        if (lane == 63) { Bc[cc] = b1; CMX[cc] = cm1; } }
    __syncthreads();
    if (tid == 0) { float m = 0.f;
        for (int cc = 0; cc < 16; ++cc) { MC[cc] = m; const float mn = Bc[cc] + fmaxf(m, CMX[cc]); DEC[cc] = __expf(Bc[cc] + m - mn); m = mn; }
        MC[16] = m; }
    __syncthreads();
    for (int t = tid; t < 2048; t += 512) { const int cc = t >> 7; Gs[t] = __expf(Bc[cc] + E[t] - MC[cc + 1]) * 0.0625f; }
    if (vt == 0 && dt == 0) { if (tid < 16) MST[bh * 16 + tid] = MC[tid]; if (tid == 0) a.out[OMP + l * 16 + bh] = MC[16]; }
    f32x16 acc = zero16(), nblk = zero16();
    const int vb = wave >> 1, db = wave & 1, r = lane & 31, hh = lane >> 5;
    const bool nwave = (vt == 0 && vb == 0);
    u32x4 vrA[4], krA[2], vrB[4], krB[2];
#define SCAN_LOAD(vr, kr, cc) do { const int r0_ = b * 2048 + (cc) * 128; \
        _Pragma("unroll") for (int i2 = 0; i2 < 4; ++i2) { const int i = tid + i2 * 512, s_ = i >> 4, ch = i & 15; vr[i2] = *(const u32x4*)(P + (size_t)(r0_ + s_) * NB + 2048 + h * 256 + vt * 128 + ch * 8); } \
        _Pragma("unroll") for (int i2 = 0; i2 < 2; ++i2) { const int i = tid + i2 * 512, s_ = i >> 3, ch = i & 7; kr[i2] = *(const u32x4*)(P + (size_t)(r0_ + s_) * NB + 1024 + h * 256 + dt * 64 + ch * 8); } } while (0)
#define SCAN_STEP(vr, kr, c) do { \
        { bf16_t* cp_ = CST + ((size_t)(bh * 16 + (c)) * 256 + vt * 128 + vb * 32 + r) * 256 + dt * 64 + db * 32 + 4 * hh; \
          _Pragma("unroll") for (int q4 = 0; q4 < 4; ++q4) { u32x2 o; o.x = cvt_pk_bf16(acc[4 * q4 + 0], acc[4 * q4 + 1]); o.y = cvt_pk_bf16(acc[4 * q4 + 2], acc[4 * q4 + 3]); *(u32x2*)(cp_ + 8 * q4) = o; } } \
        if (nwave && r == 0) { _Pragma("unroll") for (int reg = 0; reg < 16; ++reg) NST[(bh * 16 + (c)) * 256 + dt * 64 + db * 32 + rowof(reg, hh)] = nblk[reg]; } \
        __syncthreads(); \
        _Pragma("unroll") for (int i2 = 0; i2 < 4; ++i2) { const int i = tid + i2 * 512, s_ = i >> 4, ch = i & 15; \
            const u32x4 raw = vr[i2]; const float g = Gs[(c) * 128 + s_]; \
            u32x4 o; o.x = cvt_pk_bf16(bflo(raw.x) * g, bfhi(raw.x) * g); o.y = cvt_pk_bf16(bflo(raw.y) * g, bfhi(raw.y) * g); \
            o.z = cvt_pk_bf16(bflo(raw.z) * g, bfhi(raw.z) * g); o.w = cvt_pk_bf16(bflo(raw.w) * g, bfhi(raw.w) * g); \
            *(LAS u32x4*)(Vt + s_ * 272 + ch * 16) = o; } \
        if (tid < 128) { u32x4 o; o.x = cvt_pk_bf16(Gs[(c) * 128 + tid], 0.f); o.y = 0u; o.z = 0u; o.w = 0u; *(LAS u32x4*)(Vt + tid * 272 + 256) = o; } \
        _Pragma("unroll") for (int i2 = 0; i2 < 2; ++i2) { const int i = tid + i2 * 512, s_ = i >> 3, ch = i & 7; *(LAS u32x4*)(Kt + s_ * 144 + ch * 16) = kr[i2]; } \
        if ((c) + 2 < 16) SCAN_LOAD(vr, kr, (c) + 2); \
        __syncthreads(); \
        { const float dec = DEC[(c)]; \
          _Pragma("unroll") for (int reg = 0; reg < 16; ++reg) { acc[reg] *= dec; nblk[reg] *= dec; } } \
        if (nwave) { \
            _Pragma("unroll") for (int ks = 0; ks < 8; ++ks) { const bf16x8 vf = frag_tr(Vt, 272, ks * 16, vb * 32, lane); const bf16x8 kf = frag_tr(Kt, 144, ks * 16, db * 32, lane); const bf16x8 gf = frag_tr(Vt, 272, ks * 16, 128, lane); \
                acc = mma32(kf, vf, acc); nblk = mma32(kf, gf, nblk); } \
        } else { \
            _Pragma("unroll") for (int ks = 0; ks < 8; ++ks) { const bf16x8 vf = frag_tr(Vt, 272, ks * 16, vb * 32, lane); const bf16x8 kf = frag_tr(Kt, 144, ks * 16, db * 32, lane); acc = mma32(kf, vf, acc); } \
        } } while (0)
    SCAN_LOAD(vrA, krA, 0); SCAN_LOAD(vrB, krB, 1);
#pragma unroll 1
    for (int c = 0; c < 16; c += 2) { SCAN_STEP(vrA, krA, c); SCAN_STEP(vrB, krB, c + 1); }
#undef SCAN_LOAD
#undef SCAN_STEP
    { float* op_ = a.out + OCP + ((size_t)(l * 16 + bh) * 256 + vt * 128 + vb * 32 + r) * 256 + dt * 64 + db * 32 + 4 * hh;
#pragma unroll
      for (int q4 = 0; q4 < 4; ++q4) *(f32x4*)(op_ + 8 * q4) = (f32x4){acc[4 * q4 + 0], acc[4 * q4 + 1], acc[4 * q4 + 2], acc[4 * q4 + 3]}; }
    if (nwave && r == 0) {
#pragma unroll
        for (int reg = 0; reg < 16; ++reg) a.out[ONP + (l * 16 + bh) * 256 + dt * 64 + db * 32 + rowof(reg, hh)] = nblk[reg]; }
    __syncthreads();
}

__device__ __forceinline__ void mix_item(const Args& a, int l, int item, LAS unsigned char* lds, int tid, int lane, int wave) {
    const int b = item >> 6, c = (item >> 2) & 15, g = item & 3, r0 = b * 2048 + c * 128;
    LAS unsigned char* VN = lds;
    LAS unsigned char* WW = lds + 67584;
    const bf16_t* P = (const bf16_t*)(a.ws + WS_P);
    bf16_t* ACT = (bf16_t*)(a.ws + WS_ACT);
    const float* ws_ = a.in[15] + (size_t)(l * 4 + g) * 128 * 128;
#pragma unroll
    for (int i2 = 0; i2 < 8; ++i2) { const int i = tid + i2 * 512, t = i >> 5, s4 = (i & 31) * 4;
        f32x4 w = *(const f32x4*)(ws_ + t * 128 + s4);
        if (s4 + 0 > t) w[0] = 0.f; if (s4 + 1 > t) w[1] = 0.f; if (s4 + 2 > t) w[2] = 0.f; if (s4 + 3 > t) w[3] = 0.f;
        u32x2 o; o.x = cvt_pk_bf16(w[0], w[1]); o.y = cvt_pk_bf16(w[2], w[3]);
        *(LAS u32x2*)(WW + t * 272 + s4 * 2) = o; }
    const f32x4 gc = *(const f32x4*)(a.in[14] + l * 1024 + g * 256 + lane * 4);
    u32x2 vraw[16];
#pragma unroll
    for (int i = 0; i < 16; ++i) vraw[i] = *(const u32x2*)(P + (size_t)(r0 + wave * 16 + i) * NB + 6144 + g * 256 + lane * 4);
#pragma unroll
    for (int i = 0; i < 16; ++i) { const int s = wave * 16 + i;
        const u32x2 raw = vraw[i];
        float x0 = geluf_(bflo(raw.x)), x1 = geluf_(bfhi(raw.x)), x2 = geluf_(bflo(raw.y)), x3 = geluf_(bfhi(raw.y));
        const float mean = wave_sum((x0 + x1) + (x2 + x3)) * (1.0f / 256.0f);
        x0 -= mean; x1 -= mean; x2 -= mean; x3 -= mean;
        const float rstd = rsqrtf(wave_sum((x0 * x0 + x1 * x1) + (x2 * x2 + x3 * x3)) * (1.0f / 256.0f) + EPS);
        u32x2 o; o.x = cvt_pk_bf16(x0 * rstd * gc[0], x1 * rstd * gc[1]); o.y = cvt_pk_bf16(x2 * rstd * gc[2], x3 * rstd * gc[3]);
        *(LAS u32x2*)(VN + s * 528 + lane * 8) = o; }
    __syncthreads();
    const int tb = wave >> 1, cb0 = (wave & 1) * 4, r = lane & 31, hh = lane >> 5;
    f32x16 acc[4];
#pragma unroll
    for (int j = 0; j < 4; ++j) acc[j] = zero16();
    for (int ks = 0; ks < 2 * (tb + 1); ++ks) { const bf16x8 wf = frag_row(WW, 272, tb * 32, ks * 16, lane);
#pragma unroll
        for (int j = 0; j < 4; ++j) { const bf16x8 vf = frag_tr(VN, 528, ks * 16, (cb0 + j) * 32, lane); acc[j] = mma32(vf, wf, acc[j]); } }
    { const int t = tb * 32 + r; const float bias = a.in[16][(l * 4 + g) * 128 + t];
      const bf16_t* prow = P + (size_t)(r0 + t) * NB + g * 256 + 4 * hh; bf16_t* arow = ACT + (size_t)(r0 + t) * D + 1024 + g * 256 + 4 * hh;
#pragma unroll
      for (int j = 0; j < 4; ++j)
#pragma unroll
        for (int q4 = 0; q4 < 4; ++q4) { const int chb = (cb0 + j) * 32 + 8 * q4;
            const u32x2 ur = *(const u32x2*)(prow + 5120 + chb), zr = *(const u32x2*)(prow + 7168 + chb);
            const float o0 = geluf_(bflo(ur.x)) * (acc[j][4 * q4 + 0] + bias) * siluf_(bflo(zr.x)), o1 = geluf_(bfhi(ur.x)) * (acc[j][4 * q4 + 1] + bias) * siluf_(bfhi(zr.x));
            const float o2 = geluf_(bflo(ur.y)) * (acc[j][4 * q4 + 2] + bias) * siluf_(bflo(zr.y)), o3 = geluf_(bfhi(ur.y)) * (acc[j][4 * q4 + 3] + bias) * siluf_(bfhi(zr.y));
            u32x2 o; o.x = cvt_pk_bf16(o0, o1); o.y = cvt_pk_bf16(o2, o3); *(u32x2*)(arow + chb) = o; } }
    __syncthreads();
}

__device__ __forceinline__ void sample_item(const Args& a, int l, int item, LAS unsigned char* lds, int tid, int lane, int wave) {
    const int rr = item >> 2, h = item & 3, R = MP + rr;
    LAS float* q = (LAS float*)lds; LAS float* k = q + 256; LAS float* vv = q + 512; LAS float* n0 = q + 768; LAS float* CQ = q + 1024; LAS float* HH = q + 1280; LAS float* RED = q + 1536;
    const bf16_t* P = (const bf16_t*)(a.ws + WS_P);
    bf16_t* ACT = (bf16_t*)(a.ws + WS_ACT);
    const bf16_t* prow = P + (size_t)R * NB;
    const size_t sidx = (size_t)(l * 128 + rr) * 4 + h;
    if (tid < 256) { q[tid] = bf2f(prow[h * 256 + tid]); k[tid] = bf2f(prow[1024 + h * 256 + tid]) * 0.0625f; vv[tid] = bf2f(prow[2048 + h * 256 + tid]); n0[tid] = a.in[3][sidx * 256 + tid]; }
    __syncthreads();
    const float ig = ((const float*)(a.ws + WS_IG))[R * 4 + h], lf = ((const float*)(a.ws + WS_LF))[R * 4 + h], m0 = a.in[4][sidx];
    const float a_ = lf + m0, mt = fmaxf(a_, ig), wintra = __expf(ig - mt), winter = __expf(a_ - mt);
    const f32x4 q4 = *(const LAS f32x4*)(q + lane * 4), k4 = *(const LAS f32x4*)(k + lane * 4), n4 = *(const LAS f32x4*)(n0 + lane * 4);
    const float qk = wave_sum((q4[0] * k4[0] + q4[1] * k4[1]) + (q4[2] * k4[2] + q4[3] * k4[3]));
    const float nq = wave_sum((q4[0] * n4[0] + q4[1] * n4[1]) + (q4[2] * n4[2] + q4[3] * n4[3]));
    const float s = qk * wintra, den = winter * nq + s, inv = 1.0f / fmaxf(fabsf(den), __expf(-mt));
    const float* C0 = a.in[2] + sidx * 65536; float* C1 = a.out + OCS + sidx * 65536;
#pragma unroll 1
    for (int i0 = 0; i0 < 32; i0 += 16) {
        f32x4 c4[16];
#pragma unroll
        for (int i = 0; i < 16; ++i) c4[i] = __builtin_nontemporal_load((const f32x4*)(C0 + (size_t)(wave * 32 + i0 + i) * 256 + lane * 4));
#pragma unroll
        for (int i = 0; i < 16; ++i) { const int vrow = wave * 32 + i0 + i;
            float dot = (c4[i][0] * q4[0] + c4[i][1] * q4[1]) + (c4[i][2] * q4[2] + c4[i][3] * q4[3]);
            const float gv = wintra * vv[vrow];
            const f32x4 cn = c4[i] * winter + k4 * gv;
            __builtin_nontemporal_store(cn, (f32x4*)(C1 + (size_t)vrow * 256 + lane * 4));
            dot = wave_sum(dot); if (lane == 0) CQ[vrow] = dot; } }
    __syncthreads();
    float hv = 0.f, xg = 0.f;
    if (tid < 256) { const float num = winter * CQ[tid] + s * vv[tid]; hv = num * inv * sigmoidf_(bf2f(prow[3072 + h * 256 + tid])); HH[tid] = hv;
        a.out[ONS + sidx * 256 + tid] = winter * n0[tid] + wintra * k[tid];
        const float p = wave_sum(hv * hv); if (lane == 0) RED[wave] = p; }
    else { xg = geluf_(bf2f(prow[6144 + h * 256 + (tid - 256)])); const float p = wave_sum(xg); if (lane == 0) RED[wave] = p; }
    if (tid == 0) a.out[OMS + sidx] = mt;
    __syncthreads();
    if (tid < 256) { const float rstd = rsqrtf(((RED[0] + RED[1]) + (RED[2] + RED[3])) * (1.0f / 256.0f) + EPS);
        ACT[(size_t)R * D + h * 256 + tid] = f2bf(hv * rstd * a.in[13][l * 1024 + h * 256 + tid] * siluf_(bf2f(prow[4096 + h * 256 + tid]))); }
    else { const float mean = ((RED[4] + RED[5]) + (RED[6] + RED[7])) * (1.0f / 256.0f); xg -= mean; const float p = wave_sum(xg * xg); if (lane == 0) RED[4 + wave] = p; }
    __syncthreads();
    if (tid >= 256) { const int ch = tid - 256; const float rstd = rsqrtf(((RED[8] + RED[9]) + (RED[10] + RED[11])) * (1.0f / 256.0f) + EPS);
        const float vn = xg * rstd * a.in[14][l * 1024 + h * 256 + ch];
        a.out[OVS + (size_t)(l * 128 + rr) * 1024 + h * 256 + ch] = vn;
        const float w00 = a.in[15][(size_t)(l * 4 + h) * 16384], b0 = a.in[16][(l * 4 + h) * 128];
        ACT[(size_t)R * D + 1024 + h * 256 + ch] = f2bf(geluf_(bf2f(prow[5120 + h * 256 + ch])) * (w00 * vn + b0) * siluf_(bf2f(prow[7168 + h * 256 + ch]))); }
    __syncthreads();
}

__device__ __forceinline__ void mlstm_out_item(const Args& a, int l, int item, LAS unsigned char* lds, int tid, int lane, int wave) {
    const int bh = item >> 4, c = item & 15, b = bh >> 2, h = bh & 3, r0 = b * 2048 + c * 128;
    LAS unsigned char* KC = lds;
    LAS unsigned char* SS = lds + 67584;
    LAS unsigned char* VV = lds + 67584 + 34816;
    LAS float* SM = (LAS float*)(lds + 137216);
    LAS float* E = SM; LAS float* MX = SM + 128; LAS float* BT = SM + 256; LAS float* NQ = SM + 384; LAS float* INV = SM + 512; LAS float* WI = SM + 640; LAS float* SSQ = SM + 768; LAS float* NV = SM + 1024;
    const bf16_t* P = (const bf16_t*)(a.ws + WS_P);
    bf16_t* ACT = (bf16_t*)(a.ws + WS_ACT);
    const bf16_t* CST = (const bf16_t*)(a.ws + WS_CST) + (size_t)(bh * 16 + c) * 65536;
    const int tb = wave >> 1, sub = wave & 1, r = lane & 31, hh = lane >> 5;
    const float m_c = ((const float*)(a.ws + WS_MST))[bh * 16 + c];
    if (wave == 0) { float b0, b1, e0, e1, cm0, cm1;
        chunk_scan((const float*)(a.ws + WS_IG), (const float*)(a.ws + WS_LF), r0, h, lane, b0, b1, e0, e1, cm0, cm1);
        E[2 * lane] = e0; E[2 * lane + 1] = e1; MX[2 * lane] = fmaxf(m_c, cm0); MX[2 * lane + 1] = fmaxf(m_c, cm1); BT[2 * lane] = b0; BT[2 * lane + 1] = b1; }
    if (tid < 256) NV[tid] = ((const float*)(a.ws + WS_NST))[(bh * 16 + c) * 256 + tid];
#pragma unroll
    for (int i2 = 0; i2 < 8; ++i2) { const int i = tid + i2 * 512, s = i >> 5, ch = i & 31;
        *(LAS u32x4*)(KC + s * 528 + ch * 16) = *(const u32x4*)(P + (size_t)(r0 + s) * NB + 1024 + h * 256 + ch * 8); }
    bf16x8 qf[16];
    { const bf16_t* qrow = P + (size_t)(r0 + tb * 32 + r) * NB + h * 256 + 8 * hh;
#pragma unroll
      for (int ks = 0; ks < 16; ++ks) qf[ks] = *(const bf16x8*)(qrow + ks * 16); }
    __syncthreads();
    u32x4 vpre[4], cpre[8];
#define MO_LOAD(hv_) do { \
        _Pragma("unroll") for (int i2 = 0; i2 < 4; ++i2) { const int i = tid + i2 * 512, s_ = i >> 4, ch = i & 15; vpre[i2] = *(const u32x4*)(P + (size_t)(r0 + s_) * NB + 2048 + h * 256 + (hv_) * 128 + ch * 8); } \
        _Pragma("unroll") for (int i2 = 0; i2 < 8; ++i2) { const int i = tid + i2 * 512, v_ = i >> 5, ch = i & 31; cpre[i2] = *(const u32x4*)(CST + (size_t)((hv_) * 128 + v_) * 256 + ch * 8); } } while (0)
#define MO_STORE() do { \
        _Pragma("unroll") for (int i2 = 0; i2 < 4; ++i2) { const int i = tid + i2 * 512, s_ = i >> 4, ch = i & 15; *(LAS u32x4*)(VV + s_ * 272 + ch * 16) = vpre[i2]; } \
        _Pragma("unroll") for (int i2 = 0; i2 < 8; ++i2) { const int i = tid + i2 * 512, v_ = i >> 5, ch = i & 31; *(LAS u32x4*)(KC + v_ * 528 + ch * 16) = cpre[i2]; } } while (0)
    MO_LOAD(0);
    if (sub == 0) { float p = 0.f;
#pragma unroll
        for (int ks = 0; ks < 16; ++ks)
#pragma unroll
            for (int j = 0; j < 8; ++j) p += bf2f((bf16_t)qf[ks][j]) * NV[16 * ks + 8 * hh + j];
        p += __shfl_xor(p, 32); if (hh == 0) NQ[tb * 32 + r] = p; }
    const int t = tb * 32 + r;
#pragma unroll
    for (int jb = 0; jb < 2; ++jb) { const int sb = 2 * sub + jb;
        if (sb <= tb) { f32x16 acc = zero16();
#pragma unroll
            for (int ks = 0; ks < 16; ++ks) { const bf16x8 kf = frag_row(KC, 528, sb * 32, ks * 16, lane); acc = mma32(kf, qf[ks], acc); }
            const float mxt = MX[t];
#pragma unroll
            for (int q4 = 0; q4 < 4; ++q4) { const int s0 = sb * 32 + 8 * q4 + 4 * hh; const f32x4 e4 = *(const LAS f32x4*)(E + s0);
                const float w0 = (s0 + 0 <= t) ? __expf(e4[0] - mxt) * 0.0625f : 0.f, w1 = (s0 + 1 <= t) ? __expf(e4[1] - mxt) * 0.0625f : 0.f;
                const float w2 = (s0 + 2 <= t) ? __expf(e4[2] - mxt) * 0.0625f : 0.f, w3 = (s0 + 3 <= t) ? __expf(e4[3] - mxt) * 0.0625f : 0.f;
                u32x2 o; o.x = cvt_pk_bf16(acc[4 * q4 + 0] * w0, acc[4 * q4 + 1] * w1); o.y = cvt_pk_bf16(acc[4 * q4 + 2] * w2, acc[4 * q4 + 3] * w3);
                *(LAS u32x2*)(SS + t * 272 + s0 * 2) = o; } } }
    __syncthreads();
    f32x16 hval[2][2];
#pragma unroll
    for (int hv = 0; hv < 2; ++hv) {
        if (hv) __syncthreads();
        MO_STORE();
        u32x2 og[2][4];
#pragma unroll
        for (int jb = 0; jb < 2; ++jb)
#pragma unroll
            for (int q4 = 0; q4 < 4; ++q4) og[jb][q4] = *(const u32x2*)(P + (size_t)(r0 + t) * NB + 3072 + h * 256 + hv * 128 + (2 * sub + jb) * 32 + 4 * hh + 8 * q4);
        if (hv == 0) MO_LOAD(1);
        if (hv == 0) { const int tt = tid >> 2, part = tid & 3; float sum = 0.f;
            if (part <= (tt >> 5)) {
#pragma unroll
                for (int j = 0; j < 4; ++j) { const u32x4 w = *(const LAS u32x4*)(SS + tt * 272 + part * 64 + j * 16);
                    sum += (bflo(w.x) + bfhi(w.x)) + (bflo(w.y) + bfhi(w.y)) + (bflo(w.z) + bfhi(w.z)) + (bflo(w.w) + bfhi(w.w)); } }
            sum += __shfl_xor(sum, 1); sum += __shfl_xor(sum, 2);
            if (part == 0) { const float wi = __expf(m_c - MX[tt]); const float den = wi * NQ[tt] + sum; const float mt = BT[tt] + MX[tt];
                INV[tt] = 1.0f / fmaxf(fabsf(den), __expf(-mt)); WI[tt] = wi; } }
        __syncthreads();
        const float wi = WI[t], inv = INV[t];
#pragma unroll
        for (int jb = 0; jb < 2; ++jb) { const int vb = 2 * sub + jb; f32x16 acc = zero16();
#pragma unroll
            for (int ks = 0; ks < 16; ++ks) { const bf16x8 cf = frag_row(KC, 528, vb * 32, ks * 16, lane); acc = mma32(cf, qf[ks], acc); }
#pragma unroll
            for (int reg = 0; reg < 16; ++reg) acc[reg] *= wi;
            for (int ks = 0; ks < 2 * (tb + 1); ++ks) { const bf16x8 sf = frag_row(SS, 272, tb * 32, ks * 16, lane); const bf16x8 vf = frag_tr(VV, 272, ks * 16, vb * 32, lane); acc = mma32(vf, sf, acc); }
#pragma unroll
            for (int q4 = 0; q4 < 4; ++q4) { const u32x2 raw = og[jb][q4];
                acc[4 * q4 + 0] *= inv * sigmoidf_(bflo(raw.x)); acc[4 * q4 + 1] *= inv * sigmoidf_(bfhi(raw.x));
                acc[4 * q4 + 2] *= inv * sigmoidf_(bflo(raw.y)); acc[4 * q4 + 3] *= inv * sigmoidf_(bfhi(raw.y)); }
            hval[hv][jb] = acc; }
    }
#undef MO_LOAD
#undef MO_STORE
    const bf16_t* zrow = P + (size_t)(r0 + t) * NB + 4096 + h * 256 + 4 * hh;
    u32x2 zr[2][2][4];
#pragma unroll
    for (int hv = 0; hv < 2; ++hv)
#pragma unroll
        for (int jb = 0; jb < 2; ++jb)
#pragma unroll
            for (int q4 = 0; q4 < 4; ++q4) zr[hv][jb][q4] = *(const u32x2*)(zrow + hv * 128 + (2 * sub + jb) * 32 + 8 * q4);
    { float s2 = 0.f;
#pragma unroll
      for (int reg = 0; reg < 16; ++reg) s2 += (hval[0][0][reg] * hval[0][0][reg] + hval[0][1][reg] * hval[0][1][reg]) + (hval[1][0][reg] * hval[1][0][reg] + hval[1][1][reg] * hval[1][1][reg]);
      s2 += __shfl_xor(s2, 32);
      if (hh == 0) SSQ[sub * 128 + t] = s2; }
    __syncthreads();
    { const float rstd = rsqrtf((SSQ[t] + SSQ[128 + t]) * (1.0f / 256.0f) + EPS);
      const float* gm = a.in[13] + l * 1024 + h * 256 + 4 * hh;
      bf16_t* arow = ACT + (size_t)(r0 + t) * D + h * 256 + 4 * hh;
#pragma unroll
      for (int hv = 0; hv < 2; ++hv)
#pragma unroll
        for (int jb = 0; jb < 2; ++jb)
#pragma unroll
            for (int q4 = 0; q4 < 4; ++q4) { const int cb = hv * 128 + (2 * sub + jb) * 32 + 8 * q4;
                const u32x2 z2 = zr[hv][jb][q4]; const f32x4 g4 = *(const f32x4*)(gm + cb);
                u32x2 o; o.x = cvt_pk_bf16(hval[hv][jb][4 * q4 + 0] * rstd * g4[0] * siluf_(bflo(z2.x)), hval[hv][jb][4 * q4 + 1] * rstd * g4[1] * siluf_(bfhi(z2.x)));
                o.y = cvt_pk_bf16(hval[hv][jb][4 * q4 + 2] * rstd * g4[2] * siluf_(bflo(z2.y)), hval[hv][jb][4 * q4 + 3] * rstd * g4[3] * siluf_(bfhi(z2.y)));
                *(u32x2*)(arow + cb) = o; } }
    __syncthreads();
}

__device__ __forceinline__ void phase_final(const Args& a, int tid, int lane, int wave, int G, int bid) {
    const float* gf = a.in[18];
    for (int r = bid * 8 + wave; r < MT; r += G * 8) {
        float* xr = a.out + OY + (size_t)r * D + lane * 4;
        f32x4 v[8]; float ss = 0.f;
#pragma unroll
        for (int i = 0; i < 8; ++i) { v[i] = *(const f32x4*)(xr + 256 * i); ss += (v[i][0] * v[i][0] + v[i][1] * v[i][1]) + (v[i][2] * v[i][2] + v[i][3] * v[i][3]); }
        const float rstd = rsqrtf(wave_sum(ss) * (1.0f / D) + EPS);
#pragma unroll
        for (int i = 0; i < 8; ++i) { const f32x4 g = *(const f32x4*)(gf + lane * 4 + 256 * i); *(f32x4*)(xr + 256 * i) = v[i] * rstd * g; }
    }
}

__global__ void __launch_bounds__(512, 2) fwd_megakernel(Args a) {
    extern __shared__ __attribute__((aligned(16))) unsigned char lds_raw[];
    LAS unsigned char* lds = (LAS unsigned char*)lds_raw;
    cg::grid_group grid = cg::this_grid();
    const int G = gridDim.x, bid = blockIdx.x;
    const int lo = a.ph_lo, hi = a.ph_hi;
    if (hi > NPHASE) grid.sync();
    if (threadIdx.x < 4) ((LAS unsigned*)(lds + LDS_BYTES - 16))[threadIdx.x] = 0u;
    __syncthreads();
    const XcdBarrier xbar = xcd_barrier_post((unsigned*)a.ws, (volatile LAS unsigned*)(lds + LDS_BYTES - 16));
#define IN(k) (lo <= (k) && (k) < hi)
#define SEAM(k) do { if (IN(k) && IN((k) + 1)) { xcd_barrier(xbar); if (PROBE == 20) xcd_barrier(xbar); } } while (0)
#define TIDS int tid = threadIdx.x; asm volatile("" : "+v"(tid)); const int lane = tid & 63, wave = __builtin_amdgcn_readfirstlane(tid >> 6);
#define REPEAT(n) for (int rep_ = 0; rep_ < ((PROBE == (n)) ? 2 : 1); ++rep_)
#define RSYNC(n) do { if (PROBE == (n) && rep_ == 0) xcd_barrier(xbar); } while (0)
    REPEAT(1) { if (IN(0)) { TIDS phase0(a, lds, tid, lane, wave, G, bid); } RSYNC(1); }
    SEAM(0);
    REPEAT(2) { if (IN(1)) {
            unsigned* qctr = (unsigned*)a.ws + 3584 + (4 + rep_) * 64;
            volatile LAS unsigned* qw = (volatile LAS unsigned*)(lds + LDS_BYTES - 32);
#pragma unroll 1
            for (;;) { TIDS
                if (tid == 0) qw[0] = __hip_atomic_fetch_add(qctr, 1u, __ATOMIC_RELAXED, __HIP_MEMORY_SCOPE_AGENT);
                __syncthreads();
                const int item = (int)qw[0];
                __syncthreads();
                if (item >= 384 + 2560) break;
                if (item < 384) ada_item(a, lds, item, tid, lane, wave);
                else transpose_wg_item(a, lds, item - 384, lane, wave);
            }
        } RSYNC(2); }
    SEAM(1);
#pragma unroll 1
    for (int l = 0; l < 2; ++l) {
        const int pb = 2 + 5 * l;
        REPEAT(3) { if (IN(pb)) { TIDS phase_norm(a, l, lds, tid, lane, wave, G, bid); } RSYNC(3); }
        SEAM(pb);
        REPEAT(4) { if (IN(pb + 1)) {
            pg8::Gemm g{(const bf16_t*)(a.ws + WS_HN), (const bf16_t*)(a.ws + WS_WIN) + (size_t)l * NB * D, MP, NB, D};
            pg8::StaticOrder S; S.init(MP, NB, G, bid);
            pg8::EpiP E{(bf16_t*)(a.ws + WS_P), NB};
            pg8::gemm_phase<pg8::EpiP, pg8::StaticOrder>(lds, g, S, E);
#pragma unroll 1
            for (int item = bid; item < 256; item += G) { TIDS skinny_item<0>(a, l, item * 32, (const bf16_t*)(a.ws + WS_HN) + (size_t)MP * D, (const bf16_t*)(a.ws + WS_WIN) + (size_t)l * NB * D, lds, tid, lane, wave); }
        } RSYNC(4); }
        SEAM(pb + 1);
        REPEAT(5) { if (IN(pb + 2)) {
            unsigned* qctr = (unsigned*)a.ws + 3584 + (l * 2 + rep_) * 64;
            volatile LAS unsigned* qw = (volatile LAS unsigned*)(lds + LDS_BYTES - 32);
#pragma unroll 1
            for (;;) { TIDS
                if (tid == 0) qw[0] = __hip_atomic_fetch_add(qctr, 1u, __ATOMIC_RELAXED, __HIP_MEMORY_SCOPE_AGENT);
                __syncthreads();
                const int item = (int)qw[0];
                __syncthreads();
                if (item >= 896) break;
                if (item < 128) { scan_item(a, l, item, lds, tid, lane, wave); if (PROBE == 8) scan_item(a, l, item, lds, tid, lane, wave); }
                else if (item < 384) { mix_item(a, l, item - 128, lds, tid, lane, wave); if (PROBE == 9) mix_item(a, l, item - 128, lds, tid, lane, wave); }
                else { sample_item(a, l, item - 384, lds, tid, lane, wave); if (PROBE == 10) sample_item(a, l, item - 384, lds, tid, lane, wave); }
            }
        } RSYNC(5); }
        SEAM(pb + 2);
        REPEAT(6) { if (IN(pb + 3)) {
#pragma unroll 1
            for (int item = bid; item < 320; item += G) { TIDS
                if (item < 256) mlstm_out_item(a, l, item, lds, tid, lane, wave);
                else skinny_item<1>(a, l, (item - 256) * 32, (const bf16_t*)(a.ws + WS_ACT) + (size_t)MP * D, (const bf16_t*)(a.ws + WS_WOUT) + (size_t)l * D * D, lds, tid, lane, wave); }
        } RSYNC(6); }
        SEAM(pb + 3);
        REPEAT(7) { if (IN(pb + 4)) {
            pg8::Gemm g{(const bf16_t*)(a.ws + WS_ACT), (const bf16_t*)(a.ws + WS_WOUT) + (size_t)l * D * D, MP, D, D};
            pg8::StaticOrder S; S.init(MP, D, G, bid);
            pg8::EpiRes E{l == 0 ? a.in[0] : (const float*)(a.ws + WS_X1), l == 0 ? a.in[1] : (const float*)(a.ws + WS_X1) + (size_t)MP * D,
                          l == 0 ? (float*)(a.ws + WS_X1) : a.out + OY, (const float*)(a.ws + WS_MOD) + (size_t)l * NCR * NMOD};
            pg8::gemm_phase<pg8::EpiRes, pg8::StaticOrder>(lds, g, S, E);
        } RSYNC(7); }
        SEAM(pb + 4);
    }
    if (IN(12)) { TIDS phase_final(a, tid, lane, wave, G, bid); }
#undef TIDS
#undef IN
#undef SEAM
}

#ifndef N_LAUNCH_MODE
#define N_LAUNCH_MODE 1
#endif

extern "C" void kernel_launch(void* const* d_in, const int* in_sizes, int n_in, void* d_out, int out_size, void* d_ws, size_t ws_size, hipStream_t stream) {
    static int grid = 0;
    if (grid == 0) {
        int dev = 0, cus = 0, per_cu = 0;
        hipGetDevice(&dev);
        hipDeviceGetAttribute(&cus, hipDeviceAttributeMultiprocessorCount, dev);
        hipFuncSetAttribute((const void*)fwd_megakernel, hipFuncAttributeMaxDynamicSharedMemorySize, LDS_BYTES);
        hipOccupancyMaxActiveBlocksPerMultiprocessor(&per_cu, (const void*)fwd_megakernel, 512, LDS_BYTES);
        if (per_cu < 1) { fprintf(stderr, "occupancy query returned %d\n", per_cu); per_cu = 1; }
        grid = cus * per_cu;
        if (n_in != 19 || ws_size < WS_END) { fprintf(stderr, "unexpected n_in %d / ws %zu\n", n_in, ws_size); }
    }
    (void)hipMemsetAsync(d_ws, 0, 16384, stream);
    Args a{};
    for (int i = 0; i < 19; ++i) a.in[i] = (const float*)d_in[i];
    a.out = (float*)d_out; a.ws = (unsigned char*)d_ws;
#if N_LAUNCH_MODE == 1
    a.ph_lo = 0; a.ph_hi = NPHASE;
    void* args[] = {&a};
    hipError_t e = hipLaunchCooperativeKernel((const void*)fwd_megakernel, dim3(grid), dim3(512), args, LDS_BYTES, stream);
    if (e != hipSuccess) fprintf(stderr, "cooperative launch failed: %s (grid %d)\n", hipGetErrorString(e), grid);
#else
    for (int p = 0; p < NPHASE; ++p) {
        a.ph_lo = p; a.ph_hi = p + 1;
        void* args[] = {&a};
        hipError_t e = hipLaunchCooperativeKernel((const void*)fwd_megakernel, dim3(grid), dim3(512), args, LDS_BYTES, stream);
        if (e != hipSuccess) { fprintf(stderr, "launch %d failed: %s (grid %d)\n", p, hipGetErrorString(e), grid); break; }
    }
#endif
}
```

```cpp
#include <hip/hip_runtime.h>
#include <hip/hip_cooperative_groups.h>
#include <cstdio>
namespace cg = cooperative_groups;

#define LAS __attribute__((address_space(3)))
typedef unsigned short bf16_t;
typedef short bf16x8 __attribute__((ext_vector_type(8)));
typedef short s16x4 __attribute__((ext_vector_type(4)));
typedef float f32x4 __attribute__((ext_vector_type(4)));
typedef float f32x16 __attribute__((ext_vector_type(16)));
typedef unsigned u32x4 __attribute__((ext_vector_type(4)));
typedef unsigned u32x2 __attribute__((ext_vector_type(2)));

constexpr int D = 2048, MP = 8192, MS = 128, MT = 8320, MPAD = 8448;
constexpr int NB = 8192, DIN = 8200, NMOD = 6144, NCR = 132;
constexpr float EPS = 1e-6f;
constexpr size_t OY = 0, OCP = 17039360, ONP = 19136512, OMP = 19144704, OCS = 19144736, ONS = 86253600, OMS = 86515744, OVS = 86516768;
constexpr size_t MiB = 1u << 20;
constexpr size_t WS_WIN = 1 * MiB;
constexpr size_t WS_WOUT = 65 * MiB;
constexpr size_t WS_SC = 81 * MiB;
constexpr size_t WS_MOD = 82 * MiB;
constexpr size_t WS_HN = 90 * MiB;
constexpr size_t WS_P = 123 * MiB;
constexpr size_t WS_IG = 255 * MiB;
constexpr size_t WS_LF = 255 * MiB + 512 * 1024;
constexpr size_t WS_X1 = 256 * MiB;
constexpr size_t WS_ACT = 321 * MiB;
constexpr size_t WS_CST = 354 * MiB;
constexpr size_t WS_NST = 386 * MiB;
constexpr size_t WS_MST = 386 * MiB + 512 * 1024;
constexpr size_t WS_HNS = 387 * MiB;
constexpr size_t WS_ACTS = 388 * MiB;
constexpr size_t WS_END = 389 * MiB;
constexpr int LDS_BYTES = 155648;
constexpr int NPHASE = 13;
#ifndef PROBE
#define PROBE 0
#endif

struct Args { const float* in[19]; float* out; unsigned char* ws; int ph_lo, ph_hi; };

__device__ __forceinline__ float bf2f(bf16_t b) { return __uint_as_float(((unsigned)b) << 16); }
__device__ __forceinline__ float bflo(unsigned w) { return __uint_as_float(w << 16); }
__device__ __forceinline__ float bfhi(unsigned w) { return __uint_as_float(w & 0xffff0000u); }
__device__ __forceinline__ unsigned cvt_pk_bf16(float lo, float hi) { unsigned r; asm volatile("v_cvt_pk_bf16_f32 %0, %1, %2" : "=v"(r) : "v"(lo), "v"(hi)); return r; }
__device__ __forceinline__ bf16_t f2bf(float f) { return (bf16_t)(cvt_pk_bf16(f, 0.f) & 0xffffu); }
__device__ __forceinline__ float sigmoidf_(float x) { return 1.0f / (1.0f + __expf(-x)); }
__device__ __forceinline__ float siluf_(float x) { return x / (1.0f + __expf(-x)); }
__device__ __forceinline__ float geluf_(float x) { const float u = 1.5957691216f * (x + 0.044715f * x * x * x); return x / (1.0f + __expf(-u)); }
__device__ __forceinline__ float wave_sum(float v) {
#pragma unroll
    for (int o = 1; o < 64; o <<= 1) v += __shfl_xor(v, o);
    return v;
}
__device__ __forceinline__ int rowof(int reg, int hh) { return (reg & 3) + 8 * (reg >> 2) + 4 * hh; }
__device__ __forceinline__ bf16x8 frag_row(const LAS unsigned char* base, int ldb, int row0, int k0, int lane) {
    return *(const LAS bf16x8*)(base + (row0 + (lane & 31)) * ldb + (k0 + 8 * (lane >> 5)) * 2);
}
__device__ __forceinline__ bf16x8 frag_tr(const LAS unsigned char* base, int ldb, int k0, int n0, int lane) {
    const int hh = lane >> 5, blk = (lane >> 4) & 1, q = (lane & 15) >> 2, p = lane & 3;
    const LAS unsigned char* a = base + (k0 + 8 * hh + q) * ldb + (n0 + 16 * blk + 4 * p) * 2;
    const s16x4 lo = __builtin_amdgcn_ds_read_tr16_b64_v4i16((LAS s16x4*)a);
    const s16x4 hi = __builtin_amdgcn_ds_read_tr16_b64_v4i16((LAS s16x4*)(a + 4 * ldb));
    return (bf16x8){lo[0], lo[1], lo[2], lo[3], hi[0], hi[1], hi[2], hi[3]};
}
__device__ __forceinline__ f32x16 mma32(bf16x8 a, bf16x8 b, f32x16 c) { return __builtin_amdgcn_mfma_f32_32x32x16_bf16(a, b, c, 0, 0, 0); }
__device__ __forceinline__ f32x16 zero16() { f32x16 z;
#pragma unroll
    for (int i = 0; i < 16; ++i) z[i] = 0.f;
    return z; }

#define XB_TMO      128
#define XB_XCNT(j)  (256  + 64 * (j))
#define XB_XSUB(j)  (1280 + 64 * (j))
#define XB_XGEN(j)  (2304 + 64 * (j))
#define XB_TOP      3328
#define XB_TOPGEN   3392
#define XCD_BAR_WORDS 3456
#define XB_SPIN_CAP (1u << 18)
__device__ __forceinline__ unsigned xb_ld(unsigned* p)              { return __hip_atomic_load(p, __ATOMIC_RELAXED, __HIP_MEMORY_SCOPE_AGENT); }
__device__ __forceinline__ unsigned xb_add(unsigned* p, unsigned v) { return __hip_atomic_fetch_add(p, v, __ATOMIC_RELAXED, __HIP_MEMORY_SCOPE_AGENT); }
__device__ __forceinline__ unsigned xb_xcc_id() { return (unsigned)__builtin_amdgcn_s_getreg((3 << 11) | 20) & 0xFu; }
#define XB_SPIN(cond, bar) do { unsigned _sp = 0; while (cond) { __builtin_amdgcn_s_sleep(1); \
    if ((++_sp & 255u) == 0u) { if (xb_ld(&(bar)[XB_TMO])) break; if (_sp > XB_SPIN_CAP) { atomicAdd(&(bar)[XB_TMO], 1u); break; } } } } while (0)
struct XcdBarrier { unsigned* bar; unsigned x; volatile LAS unsigned* st; };
__device__ __forceinline__ XcdBarrier xcd_barrier_post(unsigned* bar, volatile LAS unsigned* st) {
    XcdBarrier b; b.bar = bar; b.x = xb_xcc_id(); b.st = st;
    if (threadIdx.x == 0) (void)xb_add(&bar[XB_XCNT(b.x)], 1u);
    return b;
}
__device__ __forceinline__ void xcd_barrier_complete(unsigned* bar, unsigned x, unsigned& nloc, unsigned& nx) {
    const unsigned G = gridDim.x * gridDim.y * gridDim.z;
    unsigned sum, cnt, mine, sp = 0u;
    for (;;) {
        sum = 0u; cnt = 0u; mine = 0u;
#pragma unroll
        for (unsigned j = 0; j < 16; ++j) { const unsigned c = xb_ld(&bar[XB_XCNT(j)]); sum += c; cnt += (c > 0u) ? 1u : 0u; mine = (j == x) ? c : mine; }
        if (sum == G) break;
        __builtin_amdgcn_s_sleep(1);
        if ((++sp & 255u) == 0u) { if (xb_ld(&bar[XB_TMO])) break; if (sp > XB_SPIN_CAP) { atomicAdd(&bar[XB_TMO], 1u); break; } }
    }
    nloc = mine > 0u ? mine : 1u; nx = cnt > 0u ? cnt : 1u;
}
__device__ __forceinline__ void xcd_barrier(const XcdBarrier& b) {
    asm volatile("s_waitcnt vmcnt(0)" ::: "memory");
    __syncthreads();
    if (threadIdx.x == 0) {
        unsigned* bar = b.bar;
        __builtin_amdgcn_s_waitcnt(0);
        unsigned nloc = b.st[0], nx = b.st[1];
        if (nloc == 0u) { xcd_barrier_complete(bar, b.x, nloc, nx); b.st[0] = nloc; b.st[1] = nx; }
        const unsigned old = xb_add(&bar[XB_XSUB(b.x)], 1u);
        const unsigned gen = old / nloc;
        if (old + 1u == (gen + 1u) * nloc) {
            __builtin_amdgcn_fence(__ATOMIC_RELEASE, "agent");
            asm volatile("s_waitcnt vmcnt(0)" ::: "memory");
            const unsigned og = xb_add(&bar[XB_TOP], 1u);
            const unsigned tg = og / nx;
            if (og + 1u == (tg + 1u) * nx) xb_add(&bar[XB_TOPGEN], 1u);
            else XB_SPIN(xb_ld(&bar[XB_TOPGEN]) == tg, bar);
            __builtin_amdgcn_fence(__ATOMIC_ACQUIRE, "agent");
            xb_add(&bar[XB_XGEN(b.x)], 1u);
            asm volatile("s_waitcnt vmcnt(0)" ::: "memory");
        } else {
            XB_SPIN(xb_ld(&bar[XB_XGEN(b.x)]) == gen, bar);
            __builtin_amdgcn_fence(__ATOMIC_ACQUIRE, "agent");
            asm volatile("s_waitcnt vmcnt(0)" ::: "memory");
        }
    }
    __syncthreads();
}

namespace pg8 {
constexpr int BM = 256, BK = 64, HALF = 128, HTB = HALF * BK * 2, STAGE_BYTES = 8 * HTB, NXCD = 8, WGM = 8;
__device__ __forceinline__ int lds_byte(int r, int c) { const int st = (r >> 4) * 2 + (c >> 5), rr = r & 15, cc = c & 31, ob = rr * 64 + cc * 2; return st * 1024 + (ob ^ (((ob >> 9) & 1) << 5)); }
__device__ __forceinline__ void stage_rc(int b, int& R, int& C) { const int st = b / 1024, sb = b % 1024, swz = sb ^ (((sb >> 9) & 1) << 5); R = (st >> 1) * 16 + swz / 64; C = (st & 1) * 32 + (swz % 64) / 2; }
__device__ __forceinline__ int perm32(int rho) { const int n = rho >> 4, i = rho & 15; return 8 * (i >> 2) + 4 * n + (i & 3); }
struct Unit { int pm, pn; };
struct Gemm { const bf16_t* A; const bf16_t* Bt; int M, N, K; };
struct StaticOrder {
    int nM, nN, nwg, G, c;
    __device__ void init(int M, int N, int G_, int c_) { nM = M / BM; nN = N / BM; nwg = nM * nN; G = G_; c = c_; }
    __device__ bool next(int i, Unit& u) const {
        const long L = (long)i * G + c; if (L >= nwg) return false;
        int wgid = (int)L; { const int q = nwg / NXCD, r = nwg % NXCD, xcd = wgid % NXCD, off = wgid / NXCD; wgid = (xcd < r ? xcd * (q + 1) : r * (q + 1) + (xcd - r) * q) + off; }
        const int nig = WGM * nN, gid = wgid / nig, fm = gid * WGM, gsz = (nM - fm) < WGM ? (nM - fm) : WGM;
        u.pm = fm + ((wgid % nig) % gsz); u.pn = (wgid % nig) / gsz; return true;
    }
};
struct EpiP {
    static constexpr bool PERM = true;
    bf16_t* O; int ldc;
    __device__ __forceinline__ void operator()(const f32x4 (&acc)[2][2][4][2], const Unit& u, int wr, int wc, int fr, int fq) const {
        const int row0 = u.pm * BM + wr * 64 + fr, col0 = u.pn * BM + wc * 32 + 8 * fq;
#pragma unroll
        for (int ai = 0; ai < 2; ++ai)
#pragma unroll
            for (int m = 0; m < 4; ++m) { bf16_t* rowp = O + (size_t)(row0 + ai * HALF + m * 16) * ldc + col0;
#pragma unroll
                for (int bj = 0; bj < 2; ++bj) { const f32x4 v0 = acc[ai][bj][m][0], v1 = acc[ai][bj][m][1];
                    u32x4 w; w.x = cvt_pk_bf16(v0[0], v0[1]); w.y = cvt_pk_bf16(v0[2], v0[3]); w.z = cvt_pk_bf16(v1[0], v1[1]); w.w = cvt_pk_bf16(v1[2], v1[3]);
                    *(u32x4*)(rowp + bj * HALF) = w; } }
    }
};
struct EpiRes {
    static constexpr bool PERM = false;
    const float* xp; const float* xs; float* dst; const float* mod;
    __device__ __forceinline__ void operator()(const f32x4 (&acc)[2][2][4][2], const Unit& u, int wr, int wc, int fr, int fq) const {
        const int row0 = u.pm * BM + wr * 64 + fr, col0 = u.pn * BM + wc * 32 + 4 * fq;
#pragma unroll
        for (int ai = 0; ai < 2; ++ai)
#pragma unroll
            for (int m = 0; m < 4; ++m) { const int r = row0 + ai * HALF + m * 16;
                if (r < MT) {
                    const int mrow = r < MP ? (r >> 11) : 4 + (r - MP);
                    const float* xo = (r < MP ? xp + (size_t)r * D : xs + (size_t)(r - MP) * D) + col0;
                    const float* gp = mod + (size_t)mrow * NMOD + 4096 + col0;
                    float* dp = dst + (size_t)r * D + col0;
#pragma unroll
                    for (int bj = 0; bj < 2; ++bj)
#pragma unroll
                        for (int n = 0; n < 2; ++n) { const f32x4 g = *(const f32x4*)(gp + bj * HALF + n * 16); const f32x4 x = *(const f32x4*)(xo + bj * HALF + n * 16);
                            *(f32x4*)(dp + bj * HALF + n * 16) = x + g * acc[ai][bj][m][n]; } } }
    }
};

template <class Epi, class Sched>
__device__ __forceinline__ void gemm_phase(LAS unsigned char* lds, const Gemm g, const Sched& S, const Epi& E) {
    int tid = threadIdx.x; asm volatile("" : "+v"(tid));
    const int wid = __builtin_amdgcn_readfirstlane(tid >> 6), lane = tid & 63, wr = wid >> 2, wc = wid & 3, fr = lane & 15, fq = lane >> 4;
    const int K = g.K, nt = K / BK;
    unsigned voffA[2], voffB[2];
#pragma unroll
    for (int i = 0; i < 2; ++i) { int R, C; stage_rc(tid * 16 + i * 8192, R, C); const int Rb = Epi::PERM ? ((R & ~31) + perm32(R & 31)) : R;
        voffA[i] = (unsigned)(R * K + C) * 2u; voffB[i] = (unsigned)(Rb * K + C) * 2u; }
    const size_t kstep = (size_t)(BK * 2);
    const size_t hstep = (size_t)HALF * K * 2;
    const size_t tstep = 2 * hstep;
    const unsigned ldsw = (unsigned)wid * 1024u;
    const int aoff = lds_byte(wr * 64 + fr, fq * 8), boff = lds_byte(wc * 32 + fr, fq * 8);
#define PG8_SA(b, h) (((b) * 2 + (h)) * HTB)
#define PG8_SB(b, h) ((4 + (b) * 2 + (h)) * HTB)
#define PG8_STAGE(bufoff, gbase, voff) do { _Pragma("unroll") for (int _i = 0; _i < 2; ++_i) \
        __builtin_amdgcn_global_load_lds((const unsigned*)((const char*)(gbase) + (voff)[_i]), (LAS unsigned*)(lds + (bufoff) + ldsw + _i * 8192), 16, 0, 0); } while (0)
#define PG8_LDA(dst, b, h) do { _Pragma("unroll") for (int m = 0; m < 4; ++m) _Pragma("unroll") for (int k = 0; k < 2; ++k) dst[m][k] = *(const LAS bf16x8*)(lds + PG8_SA(b, h) + aoff + m * 2048 + k * 1024); } while (0)
#define PG8_LDB(dst, b, h) do { _Pragma("unroll") for (int n = 0; n < 2; ++n) _Pragma("unroll") for (int k = 0; k < 2; ++k) dst[n][k] = *(const LAS bf16x8*)(lds + PG8_SB(b, h) + boff + n * 2048 + k * 1024); } while (0)
#define PG8_MMA(ai, bj, At, Bt) do { __builtin_amdgcn_s_setprio(1); _Pragma("unroll") for (int m = 0; m < 4; ++m) _Pragma("unroll") for (int n = 0; n < 2; ++n) _Pragma("unroll") for (int k = 0; k < 2; ++k) \
        acc[ai][bj][m][n] = __builtin_amdgcn_mfma_f32_16x16x32_bf16(Bt[n][k], At[m][k], acc[ai][bj][m][n], 0, 0, 0); __builtin_amdgcn_s_setprio(0); } while (0)
#define PG8_WAIT_V(n) asm volatile("s_waitcnt vmcnt(" #n ")" ::: "memory")
#define PG8_WAIT_L(n) asm volatile("s_waitcnt lgkmcnt(" #n ")" ::: "memory")
#define PG8_BAR __builtin_amdgcn_s_barrier()
#define PG8_SCHED __builtin_amdgcn_sched_barrier(0)
    Unit cur, nxt; int ui = 0;
    if (!S.next(0, cur)) return;
    f32x4 acc[2][2][4][2];
#pragma unroll
    for (int a = 0; a < 2; ++a)
#pragma unroll
        for (int b = 0; b < 2; ++b)
#pragma unroll
            for (int m = 0; m < 4; ++m)
#pragma unroll
                for (int n = 0; n < 2; ++n) acc[a][b][m][n] = (f32x4){0.f, 0.f, 0.f, 0.f};
    bf16x8 At[4][2], B0[2][2], B1[2][2];
    const char* cA = (const char*)g.A + (size_t)cur.pm * tstep; const char* cB = (const char*)g.Bt + (size_t)cur.pn * tstep;
    PG8_STAGE(PG8_SB(0, 0), cB, voffB); PG8_STAGE(PG8_SA(0, 0), cA, voffA); PG8_STAGE(PG8_SB(0, 1), cB + hstep, voffB); PG8_STAGE(PG8_SA(0, 1), cA + hstep, voffA);
    if (wr == 1) PG8_BAR;
    PG8_WAIT_V(4); PG8_BAR;
    PG8_STAGE(PG8_SB(1, 0), cB + kstep, voffB); PG8_STAGE(PG8_SA(1, 0), cA + kstep, voffA); PG8_STAGE(PG8_SB(1, 1), cB + hstep + kstep, voffB);
    PG8_WAIT_V(6); PG8_BAR;
    for (;;) {
        const bool has_next = S.next(ui + 1, nxt);
        const char* nA = has_next ? (const char*)g.A + (size_t)nxt.pm * tstep : cA; const char* nB = has_next ? (const char*)g.Bt + (size_t)nxt.pn * tstep : cB;
        for (int t = 0; t < nt; t += 2) {
            const bool last = (t == nt - 2);
            const char* a1 = cA + (size_t)(t + 1) * kstep;
            const char* a2 = last ? nA : cA + (size_t)(t + 2) * kstep; const char* b2 = last ? nB : cB + (size_t)(t + 2) * kstep;
            const char* a3 = a2 + kstep; const char* b3 = b2 + kstep;
            PG8_LDB(B0, 0, 0); PG8_SCHED; PG8_LDA(At, 0, 0); PG8_STAGE(PG8_SA(1, 1), a1 + hstep, voffA);
            PG8_WAIT_L(8); PG8_BAR; PG8_WAIT_L(0); PG8_MMA(0, 0, At, B0); PG8_BAR; PG8_SCHED;
            PG8_LDB(B1, 0, 1); PG8_STAGE(PG8_SB(0, 0), b2, voffB);
            PG8_BAR; PG8_WAIT_L(0); PG8_MMA(0, 1, At, B1); PG8_BAR;
            PG8_LDA(At, 0, 1); PG8_STAGE(PG8_SA(0, 0), a2, voffA);
            PG8_BAR; PG8_WAIT_L(0); PG8_MMA(1, 0, At, B0); PG8_BAR; PG8_SCHED;
            PG8_STAGE(PG8_SB(0, 1), b2 + hstep, voffB);
            PG8_WAIT_V(6); PG8_BAR; PG8_MMA(1, 1, At, B1); PG8_BAR;
            PG8_LDB(B0, 1, 0); PG8_SCHED; PG8_LDA(At, 1, 0); PG8_STAGE(PG8_SA(0, 1), a2 + hstep, voffA);
            PG8_WAIT_L(8); PG8_BAR; PG8_WAIT_L(0); PG8_MMA(0, 0, At, B0); PG8_BAR; PG8_SCHED;
            PG8_LDB(B1, 1, 1); PG8_STAGE(PG8_SB(1, 0), b3, voffB);
            PG8_BAR; PG8_WAIT_L(0); PG8_MMA(0, 1, At, B1); PG8_BAR;
            PG8_LDA(At, 1, 1); PG8_STAGE(PG8_SA(1, 0), a3, voffA);
            PG8_BAR; PG8_WAIT_L(0); PG8_MMA(1, 0, At, B0); PG8_BAR; PG8_SCHED;
            PG8_STAGE(PG8_SB(1, 1), b3 + hstep, voffB);
            PG8_WAIT_V(6); PG8_BAR; PG8_MMA(1, 1, At, B1); PG8_BAR;
        }
        E(acc, cur, wr, wc, fr, fq);
        if (!has_next) break;
#pragma unroll
        for (int a = 0; a < 2; ++a)
#pragma unroll
            for (int b = 0; b < 2; ++b)
#pragma unroll
                for (int m = 0; m < 4; ++m)
#pragma unroll
                    for (int n = 0; n < 2; ++n) acc[a][b][m][n] = (f32x4){0.f, 0.f, 0.f, 0.f};
        cur = nxt; cA = nA; cB = nB; ++ui;
    }
    PG8_WAIT_V(0);
    if (wr == 0) PG8_BAR;
    PG8_BAR;
#undef PG8_SA
#undef PG8_SB
#undef PG8_STAGE
#undef PG8_LDA
#undef PG8_LDB
#undef PG8_MMA
#undef PG8_WAIT_V
#undef PG8_WAIT_L
#undef PG8_BAR
#undef PG8_SCHED
}
}

template <int MODE>
__device__ __forceinline__ void skinny_item(const Args& a, int l, int n0, const bf16_t* Arows, const bf16_t* Bt, LAS unsigned char* lds, int tid, int lane, int wave) {
    LAS float* red = (LAS float*)lds;
    const int r = lane & 31, hh = lane >> 5;
    f32x16 acc[4];
#pragma unroll
    for (int i = 0; i < 4; ++i) acc[i] = zero16();
    const bf16_t* bp = Bt + (size_t)(n0 + r) * D + wave * 256 + 8 * hh;
    const bf16_t* ap = Arows + ((size_t)(wave * 32 + hh) * 128 + r) * 8;
#pragma unroll 8
    for (int ks = 0; ks < 16; ++ks) { const bf16x8 bf = *(const bf16x8*)(bp + ks * 16);
#pragma unroll
        for (int rb = 0; rb < 4; ++rb) { const bf16x8 af = *(const bf16x8*)(ap + ((size_t)ks * 2 * 128 + rb * 32) * 8); acc[rb] = mma32(bf, af, acc[rb]); } }
#pragma unroll
    for (int rb = 0; rb < 4; ++rb)
#pragma unroll
        for (int reg = 0; reg < 16; ++reg) red[((wave * 4 + rb) * 16 + reg) * 64 + lane] = acc[rb][reg];
    __syncthreads();
#pragma unroll
    for (int i = 0; i < 8; ++i) { const int e = tid + 512 * i; float sum = 0.f;
#pragma unroll
        for (int w = 0; w < 8; ++w) sum += red[w * 4096 + e];
        const int rb = e >> 10, reg = (e >> 6) & 15, ln = e & 63; const int m = rb * 32 + (ln & 31), n = n0 + rowof(reg, ln >> 5);
        if (MODE == 0) ((bf16_t*)(a.ws + WS_P))[(size_t)(MP + m) * NB + n] = f2bf(sum);
        else { const float* xs = l == 0 ? a.in[1] : (const float*)(a.ws + WS_X1) + (size_t)MP * D; float* dst = (l == 0 ? (float*)(a.ws + WS_X1) : a.out + OY) + (size_t)MP * D;
            const float gate = ((const float*)(a.ws + WS_MOD))[((size_t)l * NCR + 4 + m) * NMOD + 4096 + n];
            dst[(size_t)m * D + n] = xs[(size_t)m * D + n] + gate * sum; } }
    __syncthreads();
}

__device__ __forceinline__ void transpose_item(const float* W, int ldw, int nblk, bf16_t* WT, int K, int item, bool remap, LAS float* scr, int lane) {
    const int kb = item / nblk, nb = item % nblk, k0 = 64 * kb, n0 = 32 * nb;
    const int n0s = (remap && n0 >= 5120) ? n0 + 8 : n0;
    f32x4 wv[8];
#pragma unroll
    for (int i = 0; i < 8; ++i) wv[i] = *(const f32x4*)(W + (size_t)(k0 + 8 * i + (lane >> 3)) * ldw + n0s + (lane & 7) * 4);
#pragma unroll
    for (int i = 0; i < 8; ++i) { LAS float* d = scr + (8 * i + (lane >> 3)) * 33 + (lane & 7) * 4; d[0] = wv[i][0]; d[1] = wv[i][1]; d[2] = wv[i][2]; d[3] = wv[i][3]; }
    asm volatile("s_waitcnt lgkmcnt(0)" ::: "memory");
    const int c = lane & 7;
#pragma unroll
    for (int j = 0; j < 4; ++j) { const int n = (lane >> 3) + 8 * j; const LAS float* s = scr + (8 * c) * 33 + n;
        u32x4 o; o.x = cvt_pk_bf16(s[0 * 33], s[1 * 33]); o.y = cvt_pk_bf16(s[2 * 33], s[3 * 33]); o.z = cvt_pk_bf16(s[4 * 33], s[5 * 33]); o.w = cvt_pk_bf16(s[6 * 33], s[7 * 33]);
        *(u32x4*)(WT + (size_t)(n0 + n) * K + k0 + 8 * c) = o; }
    asm volatile("s_waitcnt lgkmcnt(0)" ::: "memory");
}
__device__ __forceinline__ void phase0(const Args& a, LAS unsigned char* lds, int tid, int lane, int wave, int G, int bid) {
    bf16_t* SC = (bf16_t*)(a.ws + WS_SC);
    const float* cp = a.in[5]; const float* cs = a.in[6];
    for (int i = bid * 512 + tid; i < 160 * 512; i += G * 512) {
        const int r = i >> 9, c4 = (i & 511) * 4;
        f32x4 v = (f32x4){0.f, 0.f, 0.f, 0.f};
        if (r < 4) v = *(const f32x4*)(cp + (size_t)r * D + c4); else if (r < NCR) v = *(const f32x4*)(cs + (size_t)(r - 4) * D + c4);
        u32x2 o; o.x = cvt_pk_bf16(siluf_(v[0]), siluf_(v[1])); o.y = cvt_pk_bf16(siluf_(v[2]), siluf_(v[3]));
        *(u32x2*)(SC + ((size_t)(c4 >> 3) * 160 + r) * 8 + (c4 & 7)) = o;
    }
}
__device__ __forceinline__ void transpose_wg_item(const Args& a, LAS unsigned char* lds, int wgitem, int lane, int wave) {
    LAS float* scr = (LAS float*)(lds + wave * 8448);
    constexpr int I_IN = 32 * 256, I_OUT = 32 * 64;
#pragma unroll 1
    for (int sub = 0; sub < 4; ++sub) {
        const int it = (wgitem * 4 + sub) * 8 + wave;
        if (it < 2 * I_IN) { const int l = it / I_IN, r = it % I_IN;
            transpose_item(a.in[10] + (size_t)l * D * DIN, DIN, 256, (bf16_t*)(a.ws + WS_WIN) + (size_t)l * NB * D, D, r, true, scr, lane); }
        else if (it < 2 * I_IN + 2 * I_OUT) { const int j = it - 2 * I_IN, l = j / I_OUT, r = j % I_OUT;
            transpose_item(a.in[17] + (size_t)l * D * D, D, 64, (bf16_t*)(a.ws + WS_WOUT) + (size_t)l * D * D, D, r, false, scr, lane); }
    }
}

__device__ __forceinline__ void ada_item(const Args& a, LAS unsigned char* lds, int item, int tid, int lane, int wave) {
    const bf16_t* SC = (const bf16_t*)(a.ws + WS_SC);
    float* MOD = (float*)(a.ws + WS_MOD);
    LAS float* red = (LAS float*)lds;
    const int r = lane & 31, hh = lane >> 5;
    {
        const int l = item / 192, n0 = (item % 192) * 32;
        const float* W = a.in[8] + (size_t)l * D * NMOD;
        const int kbase = wave * 256;
        f32x16 acc[5];
#pragma unroll
        for (int i = 0; i < 5; ++i) acc[i] = zero16();
#pragma unroll 4
        for (int ks = 0; ks < 16; ++ks) {
            const int k0 = kbase + ks * 16;
            const float* wp = W + (size_t)(k0 + 8 * hh) * NMOD + n0 + r;
            float wv[8];
#pragma unroll
            for (int j = 0; j < 8; ++j) wv[j] = wp[(size_t)j * NMOD];
            union { u32x4 u; bf16x8 v; } bfr;
            bfr.u.x = cvt_pk_bf16(wv[0], wv[1]); bfr.u.y = cvt_pk_bf16(wv[2], wv[3]); bfr.u.z = cvt_pk_bf16(wv[4], wv[5]); bfr.u.w = cvt_pk_bf16(wv[6], wv[7]);
#pragma unroll
            for (int rb = 0; rb < 5; ++rb) { const bf16x8 af = *(const bf16x8*)(SC + ((size_t)((k0 >> 3) + hh) * 160 + rb * 32 + r) * 8); acc[rb] = mma32(af, bfr.v, acc[rb]); }
        }
#pragma unroll
        for (int rb = 0; rb < 5; ++rb) {
#pragma unroll
            for (int reg = 0; reg < 16; ++reg) red[wave * 1024 + reg * 64 + lane] = acc[rb][reg];
            __syncthreads();
#pragma unroll
            for (int e2 = 0; e2 < 2; ++e2) { const int e = tid + e2 * 512; float s = 0.f;
#pragma unroll
                for (int w = 0; w < 8; ++w) s += red[w * 1024 + e];
                const int reg = e >> 6, ln = e & 63; const int row = rb * 32 + rowof(reg, ln >> 5), col = n0 + (ln & 31);
                if (row < NCR) MOD[((size_t)l * NCR + row) * NMOD + col] = s + a.in[9][(size_t)l * NMOD + col]; }
            __syncthreads();
        }
    }
}

__device__ __forceinline__ void phase_norm(const Args& a, int l, LAS unsigned char* lds, int tid, int lane, int wave, int G, int bid) {
    LAS float* Wg = (LAS float*)lds;
    const float* win = a.in[10] + (size_t)l * D * DIN;
    for (int k = tid; k < D; k += 512) { const f32x4 w0 = *(const f32x4*)(win + (size_t)k * DIN + 5120), w1 = *(const f32x4*)(win + (size_t)k * DIN + 5124);
        Wg[0 * D + k] = w0[0]; Wg[1 * D + k] = w0[1]; Wg[2 * D + k] = w0[2]; Wg[3 * D + k] = w0[3];
        Wg[4 * D + k] = w1[0]; Wg[5 * D + k] = w1[1]; Wg[6 * D + k] = w1[2]; Wg[7 * D + k] = w1[3]; }
    __syncthreads();
    const float* xp = l == 0 ? a.in[0] : (const float*)(a.ws + WS_X1);
    const float* xs = l == 0 ? a.in[1] : (const float*)(a.ws + WS_X1) + (size_t)MP * D;
    const float* gn = a.in[7] + (size_t)l * D;
    const float* MOD = (const float*)(a.ws + WS_MOD) + (size_t)l * NCR * NMOD;
    bf16_t* HN = (bf16_t*)(a.ws + WS_HN);
    float* IG = (float*)(a.ws + WS_IG); float* LF = (float*)(a.ws + WS_LF);
    f32x4 v[8];
    { const int r = bid * 8 + wave;
      if (r < MT) { const float* xr = (r < MP ? xp + (size_t)r * D : xs + (size_t)(r - MP) * D) + lane * 4;
#pragma unroll
          for (int i = 0; i < 8; ++i) v[i] = *(const f32x4*)(xr + 256 * i); } }
#pragma unroll 1
    for (int r = bid * 8 + wave; r < MT; r += G * 8) {
        const int rn = r + G * 8;
        f32x4 vn[8];
        if (rn < MT) { const float* xr = (rn < MP ? xp + (size_t)rn * D : xs + (size_t)(rn - MP) * D) + lane * 4;
#pragma unroll
            for (int i = 0; i < 8; ++i) vn[i] = *(const f32x4*)(xr + 256 * i); }
        const int mrow = r < MP ? (r >> 11) : 4 + (r - MP);
        const float* mp = MOD + (size_t)mrow * NMOD + lane * 4;
        float ss = 0.f;
#pragma unroll
        for (int i = 0; i < 8; ++i) ss += (v[i][0] * v[i][0] + v[i][1] * v[i][1]) + (v[i][2] * v[i][2] + v[i][3] * v[i][3]);
        const float rstd = rsqrtf(wave_sum(ss) * (1.0f / D) + EPS);
        bf16_t* hp = r < MP ? HN + (size_t)r * D + lane * 4 : (bf16_t*)(a.ws + WS_HNS) + ((size_t)(lane >> 1) * 128 + (r - MP)) * 8 + (lane & 1) * 4;
        const int hstride = r < MP ? 256 : 32768;
        float gd[8];
#pragma unroll
        for (int j = 0; j < 8; ++j) gd[j] = 0.f;
#pragma unroll
        for (int i = 0; i < 8; ++i) {
            const f32x4 g = *(const f32x4*)(gn + lane * 4 + 256 * i), sh = *(const f32x4*)(mp + 256 * i), sc = *(const f32x4*)(mp + 2048 + 256 * i);
            const f32x4 hv = v[i] * rstd * g * (sc + 1.0f) + sh;
            u32x2 o; o.x = cvt_pk_bf16(hv[0], hv[1]); o.y = cvt_pk_bf16(hv[2], hv[3]);
            *(u32x2*)(hp + (size_t)i * hstride) = o;
#pragma unroll
            for (int j = 0; j < 8; ++j) { const f32x4 w = *(const LAS f32x4*)(Wg + j * D + lane * 4 + 256 * i); gd[j] += (hv[0] * w[0] + hv[1] * w[1]) + (hv[2] * w[2] + hv[3] * w[3]); }
        }
#pragma unroll
        for (int j = 0; j < 8; ++j) gd[j] = wave_sum(gd[j]);
        if (lane < 4) {
            const float gi = lane == 0 ? gd[0] : lane == 1 ? gd[1] : lane == 2 ? gd[2] : gd[3];
            const float gf = lane == 0 ? gd[4] : lane == 1 ? gd[5] : lane == 2 ? gd[6] : gd[7];
            IG[r * 4 + lane] = gi + a.in[11][l * 4 + lane];
            const float f = gf + a.in[12][l * 4 + lane];
            LF[r * 4 + lane] = fminf(f, 0.f) - log1pf(expf(-fabsf(f)));
        }
        if (rn < MT) {
#pragma unroll
            for (int i = 0; i < 8; ++i) v[i] = vn[i]; }
    }
    __syncthreads();
}

__device__ __forceinline__ void chunk_scan(const float* IG, const float* LF, int r0, int h, int lane, float& b0, float& b1, float& e0, float& e1, float& cm0, float& cm1) {
    const float lf0 = LF[(r0 + 2 * lane) * 4 + h], lf1 = LF[(r0 + 2 * lane + 1) * 4 + h];
    const float ig0 = IG[(r0 + 2 * lane) * 4 + h], ig1 = IG[(r0 + 2 * lane + 1) * 4 + h];
    float s = lf0 + lf1;
#pragma unroll
    for (int o = 1; o < 64; o <<= 1) { const float t = __shfl_up(s, o); if (lane >= o) s += t; }
    b1 = s; b0 = s - lf1;
    e0 = ig0 - b0; e1 = ig1 - b1;
    float mx = fmaxf(e0, e1);
#pragma unroll
    for (int o = 1; o < 64; o <<= 1) { const float t = __shfl_up(mx, o); if (lane >= o) mx = fmaxf(mx, t); }
    cm1 = mx;
    const float prev = __shfl_up(mx, 1);
    cm0 = lane > 0 ? fmaxf(prev, e0) : e0;
}

__device__ __forceinline__ void scan_item(const Args& a, int l, int item, LAS unsigned char* lds, int tid, int lane, int wave) {
    const int bh = item >> 3, vt = (item >> 2) & 1, dt = item & 3, b = bh >> 2, h = bh & 3;
    LAS unsigned char* Vt = lds;
    LAS unsigned char* Kt = lds + 34816;
    LAS float* E = (LAS float*)(lds + 53248);
    LAS float* Gs = E + 2048;
    LAS float* Bc = Gs + 2048; LAS float* CMX = Bc + 16; LAS float* MC = CMX + 16; LAS float* DEC = MC + 32;
    const float* IG = (const float*)(a.ws + WS_IG); const float* LF = (const float*)(a.ws + WS_LF);
    const bf16_t* P = (const bf16_t*)(a.ws + WS_P);
    bf16_t* CST = (bf16_t*)(a.ws + WS_CST); float* NST = (float*)(a.ws + WS_NST); float* MST = (float*)(a.ws + WS_MST);
#pragma unroll
    for (int j = 0; j < 2; ++j) { const int cc = 2 * wave + j; float b0, b1, e0, e1, cm0, cm1;
        chunk_scan(IG, LF, b * 2048 + cc * 128, h, lane, b0, b1, e0, e1, cm0, cm1);
        E[cc * 128 + 2 * lane] = e0; E[cc * 128 + 2 * lane + 1] = e1;
        if (lane == 63) { Bc[cc] = b1; CMX[cc] = cm1; } }
    __syncthreads();
    if (tid == 0) { float m = 0.f;
        for (int cc = 0; cc < 16; ++cc) { MC[cc] = m; const float mn = Bc[cc] + fmaxf(m, CMX[cc]); DEC[cc] = __expf(Bc[cc] + m - mn); m = mn; }
        MC[16] = m; }
    __syncthreads();
    for (int t = tid; t < 2048; t += 512) { const int cc = t >> 7; Gs[t] = __expf(Bc[cc] + E[t] - MC[cc + 1]) * 0.0625f; }
    if (vt == 0 && dt == 0) { if (tid < 16) MST[bh * 16 + tid] = MC[tid]; if (tid == 0) a.out[OMP + l * 16 + bh] = MC[16]; }
    f32x16 acc = zero16(), nblk = zero16();
    const int vb = wave >> 1, db = wave & 1, r = lane & 31, hh = lane >> 5;
    const bool nwave = (vt == 0 && vb == 0);
    u32x4 vrA[4], krA[2], vrB[4], krB[2];
#define SCAN_LOAD(vr, kr, cc) do { const int r0_ = b * 2048 + (cc) * 128; \
        _Pragma("unroll") for (int i2 = 0; i2 < 4; ++i2) { const int i = tid + i2 * 512, s_ = i >> 4, ch = i & 15; vr[i2] = *(const u32x4*)(P + (size_t)(r0_ + s_) * NB + 2048 + h * 256 + vt * 128 + ch * 8); } \
        _Pragma("unroll") for (int i2 = 0; i2 < 2; ++i2) { const int i = tid + i2 * 512, s_ = i >> 3, ch = i & 7; kr[i2] = *(const u32x4*)(P + (size_t)(r0_ + s_) * NB + 1024 + h * 256 + dt * 64 + ch * 8); } } while (0)
#define SCAN_STEP(vr, kr, c) do { \
        { bf16_t* cp_ = CST + ((size_t)(bh * 16 + (c)) * 256 + vt * 128 + vb * 32 + r) * 256 + dt * 64 + db * 32 + 4 * hh; \
          _Pragma("unroll") for (int q4 = 0; q4 < 4; ++q4) { u32x2 o; o.x = cvt_pk_bf16(acc[4 * q4 + 0], acc[4 * q4 + 1]); o.y = cvt_pk_bf16(acc[4 * q4 + 2], acc[4 * q4 + 3]); *(u32x2*)(cp_ + 8 * q4) = o; } } \
        if (nwave && r == 0) { _Pragma("unroll") for (int reg = 0; reg < 16; ++reg) NST[(bh * 16 + (c)) * 256 + dt * 64 + db * 32 + rowof(reg, hh)] = nblk[reg]; } \
        __syncthreads(); \
        _Pragma("unroll") for (int i2 = 0; i2 < 4; ++i2) { const int i = tid + i2 * 512, s_ = i >> 4, ch = i & 15; \
            const u32x4 raw = vr[i2]; const float g = Gs[(c) * 128 + s_]; \
            u32x4 o; o.x = cvt_pk_bf16(bflo(raw.x) * g, bfhi(raw.x) * g); o.y = cvt_pk_bf16(bflo(raw.y) * g, bfhi(raw.y) * g); \
            o.z = cvt_pk_bf16(bflo(raw.z) * g, bfhi(raw.z) * g); o.w = cvt_pk_bf16(bflo(raw.w) * g, bfhi(raw.w) * g); \
            *(LAS u32x4*)(Vt + s_ * 272 + ch * 16) = o; } \
        if (tid < 128) { u32x4 o; o.x = cvt_pk_bf16(Gs[(c) * 128 + tid], 0.f); o.y = 0u; o.z = 0u; o.w = 0u; *(LAS u32x4*)(Vt + tid * 272 + 256) = o; } \
        _Pragma("unroll") for (int i2 = 0; i2 < 2; ++i2) { const int i = tid + i2 * 512, s_ = i >> 3, ch = i & 7; *(LAS u32x4*)(Kt + s_ * 144 + ch * 16) = kr[i2]; } \
        if ((c) + 2 < 16) SCAN_LOAD(vr, kr, (c) + 2); \
        __syncthreads(); \
        { const float dec = DEC[(c)]; \
          _Pragma("unroll") for (int reg = 0; reg < 16; ++reg) { acc[reg] *= dec; nblk[reg] *= dec; } } \
        if (nwave) { \
            _Pragma("unroll") for (int ks = 0; ks < 8; ++ks) { const bf16x8 vf = frag_tr(Vt, 272, ks * 16, vb * 32, lane); const bf16x8 kf = frag_tr(Kt, 144, ks * 16, db * 32, lane); const bf16x8 gf = frag_tr(Vt, 272, ks * 16, 128, lane); \
                acc = mma32(kf, vf, acc); nblk = mma32(kf, gf, nblk); } \
        } else { \
            _Pragma("unroll") for (int ks = 0; ks < 8; ++ks) { const bf16x8 vf = frag_tr(Vt, 272, ks * 16, vb * 32, lane); const bf16x8 kf = frag_tr(Kt, 144, ks * 16, db * 32, lane); acc = mma32(kf, vf, acc); } \
        } } while (0)
    SCAN_LOAD(vrA, krA, 0); SCAN_LOAD(vrB, krB, 1);
#pragma unroll 1
    for (int c = 0; c < 16; c += 2) { SCAN_STEP(vrA, krA, c); SCAN_STEP(vrB, krB, c + 1); }
#undef SCAN_LOAD
#undef SCAN_STEP
    { float* op_ = a.out + OCP + ((size_t)(l * 16 + bh) * 256 + vt * 128 + vb * 32 + r) * 256 + dt * 64 + db * 32 + 4 * hh;
#pragma unroll
      for (int q4 = 0; q4 < 4; ++q4) *(f32x4*)(op_ + 8 * q4) = (f32x4){acc[4 * q4 + 0], acc[4 * q4 + 1], acc[4 * q4 + 2], acc[4 * q4 + 3]}; }
    if (nwave && r == 0) {
#pragma unroll
        for (int reg = 0; reg < 16; ++reg) a.out[ONP + (l * 16 + bh) * 256 + dt * 64 + db * 32 + rowof(reg, hh)] = nblk[reg]; }
    __syncthreads();
}

__device__ __forceinline__ void mix_item(const Args& a, int l, int item, LAS unsigned char* lds, int tid, int lane, int wave) {
    const int b = item >> 6, c = (item >> 2) & 15, g = item & 3, r0 = b * 2048 + c * 128;
    LAS unsigned char* VN = lds;
    LAS unsigned char* WW = lds + 67584;
    const bf16_t* P = (const bf16_t*)(a.ws + WS_P);
    bf16_t* ACT = (bf16_t*)(a.ws + WS_ACT);
    const float* ws_ = a.in[15] + (size_t)(l * 4 + g) * 128 * 128;
#pragma unroll
    for (int i2 = 0; i2 < 8; ++i2) { const int i = tid + i2 * 512, t = i >> 5, s4 = (i & 31) * 4;
        f32x4 w = *(const f32x4*)(ws_ + t * 128 + s4);
        if (s4 + 0 > t) w[0] = 0.f; if (s4 + 1 > t) w[1] = 0.f; if (s4 + 2 > t) w[2] = 0.f; if (s4 + 3 > t) w[3] = 0.f;
        u32x2 o; o.x = cvt_pk_bf16(w[0], w[1]); o.y = cvt_pk_bf16(w[2], w[3]);
        *(LAS u32x2*)(WW + t * 272 + s4 * 2) = o; }
    const f32x4 gc = *(const f32x4*)(a.in[14] + l * 1024 + g * 256 + lane * 4);
    u32x2 vraw[16];
#pragma unroll
    for (int i = 0; i < 16; ++i) vraw[i] = *(const u32x2*)(P + (size_t)(r0 + wave * 16 + i) * NB + 6144 + g * 256 + lane * 4);
#pragma unroll
    for (int i = 0; i < 16; ++i) { const int s = wave * 16 + i;
        const u32x2 raw = vraw[i];
        float x0 = geluf_(bflo(raw.x)), x1 = geluf_(bfhi(raw.x)), x2 = geluf_(bflo(raw.y)), x3 = geluf_(bfhi(raw.y));
        const float mean = wave_sum((x0 + x1) + (x2 + x3)) * (1.0f / 256.0f);
        x0 -= mean; x1 -= mean; x2 -= mean; x3 -= mean;
        const float rstd = rsqrtf(wave_sum((x0 * x0 + x1 * x1) + (x2 * x2 + x3 * x3)) * (1.0f / 256.0f) + EPS);
        u32x2 o; o.x = cvt_pk_bf16(x0 * rstd * gc[0], x1 * rstd * gc[1]); o.y = cvt_pk_bf16(x2 * rstd * gc[2], x3 * rstd * gc[3]);
        *(LAS u32x2*)(VN + s * 528 + lane * 8) = o; }
    __syncthreads();
    const int tb = wave >> 1, cb0 = (wave & 1) * 4, r = lane & 31, hh = lane >> 5;
    f32x16 acc[4];
#pragma unroll
    for (int j = 0; j < 4; ++j) acc[j] = zero16();
    for (int ks = 0; ks < 2 * (tb + 1); ++ks) { const bf16x8 wf = frag_row(WW, 272, tb * 32, ks * 16, lane);
#pragma unroll
        for (int j = 0; j < 4; ++j) { const bf16x8 vf = frag_tr(VN, 528, ks * 16, (cb0 + j) * 32, lane); acc[j] = mma32(vf, wf, acc[j]); } }
    { const int t = tb * 32 + r; const float bias = a.in[16][(l * 4 + g) * 128 + t];
      const bf16_t* prow = P + (size_t)(r0 + t) * NB + g * 256 + 4 * hh; bf16_t* arow = ACT + (size_t)(r0 + t) * D + 1024 + g * 256 + 4 * hh;
#pragma unroll
      for (int j = 0; j < 4; ++j)
#pragma unroll
        for (int q4 = 0; q4 < 4; ++q4) { const int chb = (cb0 + j) * 32 + 8 * q4;
            const u32x2 ur = *(const u32x2*)(prow + 5120 + chb), zr = *(const u32x2*)(prow + 7168 + chb);
            const float o0 = geluf_(bflo(ur.x)) * (acc[j][4 * q4 + 0] + bias) * siluf_(bflo(zr.x)), o1 = geluf_(bfhi(ur.x)) * (acc[j][4 * q4 + 1] + bias) * siluf_(bfhi(zr.x));
            const float o2 = geluf_(bflo(ur.y)) * (acc[j][4 * q4 + 2] + bias) * siluf_(bflo(zr.y)), o3 = geluf_(bfhi(ur.y)) * (acc[j][4 * q4 + 3] + bias) * siluf_(bfhi(zr.y));
            u32x2 o; o.x = cvt_pk_bf16(o0, o1); o.y = cvt_pk_bf16(o2, o3); *(u32x2*)(arow + chb) = o; } }
    __syncthreads();
}

__device__ __forceinline__ void sample_item(const Args& a, int l, int item, LAS unsigned char* lds, int tid, int lane, int wave) {
    const int rr = item >> 2, h = item & 3, R = MP + rr;
    LAS float* q = (LAS float*)lds; LAS float* k = q + 256; LAS float* vv = q + 512; LAS float* n0 = q + 768; LAS float* CQ = q + 1024; LAS float* HH = q + 1280; LAS float* RED = q + 1536;
    const bf16_t* P = (const bf16_t*)(a.ws + WS_P);
    bf16_t* ACT = (bf16_t*)(a.ws + WS_ACT);
    const bf16_t* prow = P + (size_t)R * NB;
    const size_t sidx = (size_t)(l * 128 + rr) * 4 + h;
    if (tid < 256) { q[tid] = bf2f(prow[h * 256 + tid]); k[tid] = bf2f(prow[1024 + h * 256 + tid]) * 0.0625f; vv[tid] = bf2f(prow[2048 + h * 256 + tid]); n0[tid] = a.in[3][sidx * 256 + tid]; }
    __syncthreads();
    const float ig = ((const float*)(a.ws + WS_IG))[R * 4 + h], lf = ((const float*)(a.ws + WS_LF))[R * 4 + h], m0 = a.in[4][sidx];
    const float a_ = lf + m0, mt = fmaxf(a_, ig), wintra = __expf(ig - mt), winter = __expf(a_ - mt);
    const f32x4 q4 = *(const LAS f32x4*)(q + lane * 4), k4 = *(const LAS f32x4*)(k + lane * 4), n4 = *(const LAS f32x4*)(n0 + lane * 4);
    const float qk = wave_sum((q4[0] * k4[0] + q4[1] * k4[1]) + (q4[2] * k4[2] + q4[3] * k4[3]));
    const float nq = wave_sum((q4[0] * n4[0] + q4[1] * n4[1]) + (q4[2] * n4[2] + q4[3] * n4[3]));
    const float s = qk * wintra, den = winter * nq + s, inv = 1.0f / fmaxf(fabsf(den), __expf(-mt));
    const float* C0 = a.in[2] + sidx * 65536; float* C1 = a.out + OCS + sidx * 65536;
    { f32x4 c4[32];
#pragma unroll
      for (int i = 0; i < 32; ++i) c4[i] = __builtin_nontemporal_load((const f32x4*)(C0 + (size_t)(wave * 32 + i) * 256 + lane * 4));
#pragma unroll
      for (int i = 0; i < 32; ++i) { const int vrow = wave * 32 + i;
          float dot = (c4[i][0] * q4[0] + c4[i][1] * q4[1]) + (c4[i][2] * q4[2] + c4[i][3] * q4[3]);
          const float gv = wintra * vv[vrow];
          const f32x4 cn = c4[i] * winter + k4 * gv;
          __builtin_nontemporal_store(cn, (f32x4*)(C1 + (size_t)vrow * 256 + lane * 4));
          dot = wave_sum(dot); if (lane == 0) CQ[vrow] = dot; } }
    __syncthreads();
    float hv = 0.f, xg = 0.f;
    if (tid < 256) { const float num = winter * CQ[tid] + s * vv[tid]; hv = num * inv * sigmoidf_(bf2f(prow[3072 + h * 256 + tid])); HH[tid] = hv;
        a.out[ONS + sidx * 256 + tid] = winter * n0[tid] + wintra * k[tid];
        const float p = wave_sum(hv * hv); if (lane == 0) RED[wave] = p; }
    else { xg = geluf_(bf2f(prow[6144 + h * 256 + (tid - 256)])); const float p = wave_sum(xg); if (lane == 0) RED[wave] = p; }
    if (tid == 0) a.out[OMS + sidx] = mt;
    __syncthreads();
    if (tid < 256) { const float rstd = rsqrtf(((RED[0] + RED[1]) + (RED[2] + RED[3])) * (1.0f / 256.0f) + EPS);
        { const int c_ = h * 256 + tid; ((bf16_t*)(a.ws + WS_ACTS))[((size_t)(c_ >> 3) * 128 + rr) * 8 + (c_ & 7)] = f2bf(hv * rstd * a.in[13][l * 1024 + h * 256 + tid] * siluf_(bf2f(prow[4096 + h * 256 + tid]))); } }
    else { const float mean = ((RED[4] + RED[5]) + (RED[6] + RED[7])) * (1.0f / 256.0f); xg -= mean; const float p = wave_sum(xg * xg); if (lane == 0) RED[4 + wave] = p; }
    __syncthreads();
    if (tid >= 256) { const int ch = tid - 256; const float rstd = rsqrtf(((RED[8] + RED[9]) + (RED[10] + RED[11])) * (1.0f / 256.0f) + EPS);
        const float vn = xg * rstd * a.in[14][l * 1024 + h * 256 + ch];
        a.out[OVS + (size_t)(l * 128 + rr) * 1024 + h * 256 + ch] = vn;
        const float w00 = a.in[15][(size_t)(l * 4 + h) * 16384], b0 = a.in[16][(l * 4 + h) * 128];
        const int c_ = 1024 + h * 256 + ch; ((bf16_t*)(a.ws + WS_ACTS))[((size_t)(c_ >> 3) * 128 + rr) * 8 + (c_ & 7)] = f2bf(geluf_(bf2f(prow[5120 + h * 256 + ch])) * (w00 * vn + b0) * siluf_(bf2f(prow[7168 + h * 256 + ch]))); }
    __syncthreads();
}

__device__ __forceinline__ void mlstm_out_item(const Args& a, int l, int item, LAS unsigned char* lds, int tid, int lane, int wave) {
    const int bh = item >> 4, c = item & 15, b = bh >> 2, h = bh & 3, r0 = b * 2048 + c * 128;
    LAS unsigned char* KC = lds;
    LAS unsigned char* SS = lds + 67584;
    LAS unsigned char* VV = lds + 67584 + 34816;
    LAS float* SM = (LAS float*)(lds + 137216);
    LAS float* E = SM; LAS float* MX = SM + 128; LAS float* BT = SM + 256; LAS float* NQ = SM + 384; LAS float* INV = SM + 512; LAS float* WI = SM + 640; LAS float* SSQ = SM + 768; LAS float* NV = SM + 1024;
    const bf16_t* P = (const bf16_t*)(a.ws + WS_P);
    bf16_t* ACT = (bf16_t*)(a.ws + WS_ACT);
    const bf16_t* CST = (const bf16_t*)(a.ws + WS_CST) + (size_t)(bh * 16 + c) * 65536;
    const int tb = wave >> 1, sub = wave & 1, r = lane & 31, hh = lane >> 5;
    const float m_c = ((const float*)(a.ws + WS_MST))[bh * 16 + c];
    if (wave == 0) { float b0, b1, e0, e1, cm0, cm1;
        chunk_scan((const float*)(a.ws + WS_IG), (const float*)(a.ws + WS_LF), r0, h, lane, b0, b1, e0, e1, cm0, cm1);
        E[2 * lane] = e0; E[2 * lane + 1] = e1; MX[2 * lane] = fmaxf(m_c, cm0); MX[2 * lane + 1] = fmaxf(m_c, cm1); BT[2 * lane] = b0; BT[2 * lane + 1] = b1; }
    if (tid < 256) NV[tid] = ((const float*)(a.ws + WS_NST))[(bh * 16 + c) * 256 + tid];
#pragma unroll
    for (int i2 = 0; i2 < 8; ++i2) { const int i = tid + i2 * 512, s = i >> 5, ch = i & 31;
        *(LAS u32x4*)(KC + s * 528 + ch * 16) = *(const u32x4*)(P + (size_t)(r0 + s) * NB + 1024 + h * 256 + ch * 8); }
    bf16x8 qf[16];
    { const bf16_t* qrow = P + (size_t)(r0 + tb * 32 + r) * NB + h * 256 + 8 * hh;
#pragma unroll
      for (int ks = 0; ks < 16; ++ks) qf[ks] = *(const bf16x8*)(qrow + ks * 16); }
    __syncthreads();
    u32x4 vpre[4], cpre[8];
#define MO_LOAD(hv_) do { \
        _Pragma("unroll") for (int i2 = 0; i2 < 4; ++i2) { const int i = tid + i2 * 512, s_ = i >> 4, ch = i & 15; vpre[i2] = *(const u32x4*)(P + (size_t)(r0 + s_) * NB + 2048 + h * 256 + (hv_) * 128 + ch * 8); } \
        _Pragma("unroll") for (int i2 = 0; i2 < 8; ++i2) { const int i = tid + i2 * 512, v_ = i >> 5, ch = i & 31; cpre[i2] = *(const u32x4*)(CST + (size_t)((hv_) * 128 + v_) * 256 + ch * 8); } } while (0)
#define MO_STORE() do { \
        _Pragma("unroll") for (int i2 = 0; i2 < 4; ++i2) { const int i = tid + i2 * 512, s_ = i >> 4, ch = i & 15; *(LAS u32x4*)(VV + s_ * 272 + ch * 16) = vpre[i2]; } \
        _Pragma("unroll") for (int i2 = 0; i2 < 8; ++i2) { const int i = tid + i2 * 512, v_ = i >> 5, ch = i & 31; *(LAS u32x4*)(KC + v_ * 528 + ch * 16) = cpre[i2]; } } while (0)
    MO_LOAD(0);
    if (sub == 0) { float p = 0.f;
#pragma unroll
        for (int ks = 0; ks < 16; ++ks)
#pragma unroll
            for (int j = 0; j < 8; ++j) p += bf2f((bf16_t)qf[ks][j]) * NV[16 * ks + 8 * hh + j];
        p += __shfl_xor(p, 32); if (hh == 0) NQ[tb * 32 + r] = p; }
    const int t = tb * 32 + r;
#pragma unroll
    for (int jb = 0; jb < 2; ++jb) { const int sb = 2 * sub + jb;
        if (sb <= tb) { f32x16 acc = zero16();
#pragma unroll
            for (int ks = 0; ks < 16; ++ks) { const bf16x8 kf = frag_row(KC, 528, sb * 32, ks * 16, lane); acc = mma32(kf, qf[ks], acc); }
            const float mxt = MX[t];
#pragma unroll
            for (int q4 = 0; q4 < 4; ++q4) { const int s0 = sb * 32 + 8 * q4 + 4 * hh; const f32x4 e4 = *(const LAS f32x4*)(E + s0);
                const float w0 = (s0 + 0 <= t) ? __expf(e4[0] - mxt) * 0.0625f : 0.f, w1 = (s0 + 1 <= t) ? __expf(e4[1] - mxt) * 0.0625f : 0.f;
                const float w2 = (s0 + 2 <= t) ? __expf(e4[2] - mxt) * 0.0625f : 0.f, w3 = (s0 + 3 <= t) ? __expf(e4[3] - mxt) * 0.0625f : 0.f;
                u32x2 o; o.x = cvt_pk_bf16(acc[4 * q4 + 0] * w0, acc[4 * q4 + 1] * w1); o.y = cvt_pk_bf16(acc[4 * q4 + 2] * w2, acc[4 * q4 + 3] * w3);
                *(LAS u32x2*)(SS + t * 272 + s0 * 2) = o; } } }
    __syncthreads();
    f32x16 hval[2][2];
#pragma unroll
    for (int hv = 0; hv < 2; ++hv) {
        if (hv) __syncthreads();
        MO_STORE();
        u32x2 og[2][4];
#pragma unroll
        for (int jb = 0; jb < 2; ++jb)
#pragma unroll
            for (int q4 = 0; q4 < 4; ++q4) og[jb][q4] = *(const u32x2*)(P + (size_t)(r0 + t) * NB + 3072 + h * 256 + hv * 128 + (2 * sub + jb) * 32 + 4 * hh + 8 * q4);
        if (hv == 0) MO_LOAD(1);
        if (hv == 0) { const int tt = tid >> 2, part = tid & 3; float sum = 0.f;
            if (part <= (tt >> 5)) {
#pragma unroll
                for (int j = 0; j < 4; ++j) { const u32x4 w = *(const LAS u32x4*)(SS + tt * 272 + part * 64 + j * 16);
                    sum += (bflo(w.x) + bfhi(w.x)) + (bflo(w.y) + bfhi(w.y)) + (bflo(w.z) + bfhi(w.z)) + (bflo(w.w) + bfhi(w.w)); } }
            sum += __shfl_xor(sum, 1); sum += __shfl_xor(sum, 2);
            if (part == 0) { const float wi = __expf(m_c - MX[tt]); const float den = wi * NQ[tt] + sum; const float mt = BT[tt] + MX[tt];
                INV[tt] = 1.0f / fmaxf(fabsf(den), __expf(-mt)); WI[tt] = wi; } }
        __syncthreads();
        const float wi = WI[t], inv = INV[t];
#pragma unroll
        for (int jb = 0; jb < 2; ++jb) { const int vb = 2 * sub + jb; f32x16 acc = zero16();
#pragma unroll
            for (int ks = 0; ks < 16; ++ks) { const bf16x8 cf = frag_row(KC, 528, vb * 32, ks * 16, lane); acc = mma32(cf, qf[ks], acc); }
#pragma unroll
            for (int reg = 0; reg < 16; ++reg) acc[reg] *= wi;
            for (int ks = 0; ks < 2 * (tb + 1); ++ks) { const bf16x8 sf = frag_row(SS, 272, tb * 32, ks * 16, lane); const bf16x8 vf = frag_tr(VV, 272, ks * 16, vb * 32, lane); acc = mma32(vf, sf, acc); }
#pragma unroll
            for (int q4 = 0; q4 < 4; ++q4) { const u32x2 raw = og[jb][q4];
                acc[4 * q4 + 0] *= inv * sigmoidf_(bflo(raw.x)); acc[4 * q4 + 1] *= inv * sigmoidf_(bfhi(raw.x));
                acc[4 * q4 + 2] *= inv * sigmoidf_(bflo(raw.y)); acc[4 * q4 + 3] *= inv * sigmoidf_(bfhi(raw.y)); }
            hval[hv][jb] = acc; }
    }
#undef MO_LOAD
#undef MO_STORE
    const bf16_t* zrow = P + (size_t)(r0 + t) * NB + 4096 + h * 256 + 4 * hh;
    u32x2 zr[2][2][4];
#pragma unroll
    for (int hv = 0; hv < 2; ++hv)
#pragma unroll
        for (int jb = 0; jb < 2; ++jb)
#pragma unroll
            for (int q4 = 0; q4 < 4; ++q4) zr[hv][jb][q4] = *(const u32x2*)(zrow + hv * 128 + (2 * sub + jb) * 32 + 8 * q4);
    { float s2 = 0.f;
#pragma unroll
      for (int reg = 0; reg < 16; ++reg) s2 += (hval[0][0][reg] * hval[0][0][reg] + hval[0][1][reg] * hval[0][1][reg]) + (hval[1][0][reg] * hval[1][0][reg] + hval[1][1][reg] * hval[1][1][reg]);
      s2 += __shfl_xor(s2, 32);
      if (hh == 0) SSQ[sub * 128 + t] = s2; }
    __syncthreads();
    { const float rstd = rsqrtf((SSQ[t] + SSQ[128 + t]) * (1.0f / 256.0f) + EPS);
      const float* gm = a.in[13] + l * 1024 + h * 256 + 4 * hh;
      bf16_t* arow = ACT + (size_t)(r0 + t) * D + h * 256 + 4 * hh;
#pragma unroll
      for (int hv = 0; hv < 2; ++hv)
#pragma unroll
        for (int jb = 0; jb < 2; ++jb)
#pragma unroll
            for (int q4 = 0; q4 < 4; ++q4) { const int cb = hv * 128 + (2 * sub + jb) * 32 + 8 * q4;
                const u32x2 z2 = zr[hv][jb][q4]; const f32x4 g4 = *(const f32x4*)(gm + cb);
                u32x2 o; o.x = cvt_pk_bf16(hval[hv][jb][4 * q4 + 0] * rstd * g4[0] * siluf_(bflo(z2.x)), hval[hv][jb][4 * q4 + 1] * rstd * g4[1] * siluf_(bfhi(z2.x)));
                o.y = cvt_pk_bf16(hval[hv][jb][4 * q4 + 2] * rstd * g4[2] * siluf_(bflo(z2.y)), hval[hv][jb][4 * q4 + 3] * rstd * g4[3] * siluf_(bfhi(z2.y)));
                *(u32x2*)(arow + cb) = o; } }
    __syncthreads();
}

__device__ __forceinline__ void phase_final(const Args& a, int tid, int lane, int wave, int G, int bid) {
    const float* gf = a.in[18];
    for (int r = bid * 8 + wave; r < MT; r += G * 8) {
        float* xr = a.out + OY + (size_t)r * D + lane * 4;
        f32x4 v[8]; float ss = 0.f;
#pragma unroll
        for (int i = 0; i < 8; ++i) { v[i] = *(const f32x4*)(xr + 256 * i); ss += (v[i][0] * v[i][0] + v[i][1] * v[i][1]) + (v[i][2] * v[i][2] + v[i][3] * v[i][3]); }
        const float rstd = rsqrtf(wave_sum(ss) * (1.0f / D) + EPS);
#pragma unroll
        for (int i = 0; i < 8; ++i) { const f32x4 g = *(const f32x4*)(gf + lane * 4 + 256 * i); *(f32x4*)(xr + 256 * i) = v[i] * rstd * g; }
    }
}

__global__ void __launch_bounds__(512, 2) fwd_megakernel(Args a) {
    extern __shared__ __attribute__((aligned(16))) unsigned char lds_raw[];
    LAS unsigned char* lds = (LAS unsigned char*)lds_raw;
    cg::grid_group grid = cg::this_grid();
    const int G = gridDim.x, bid = blockIdx.x;
    const int lo = a.ph_lo, hi = a.ph_hi;
    if (hi > NPHASE) grid.sync();
    if (threadIdx.x < 4) ((LAS unsigned*)(lds + LDS_BYTES - 16))[threadIdx.x] = 0u;
    __syncthreads();
    const XcdBarrier xbar = xcd_barrier_post((unsigned*)a.ws, (volatile LAS unsigned*)(lds + LDS_BYTES - 16));
#define IN(k) (lo <= (k) && (k) < hi)
#define SEAM(k) do { if (IN(k) && IN((k) + 1)) { xcd_barrier(xbar); if (PROBE == 20) xcd_barrier(xbar); } } while (0)
#define TIDS int tid = threadIdx.x; asm volatile("" : "+v"(tid)); const int lane = tid & 63, wave = __builtin_amdgcn_readfirstlane(tid >> 6);
#define REPEAT(n) for (int rep_ = 0; rep_ < ((PROBE == (n)) ? 2 : 1); ++rep_)
#define RSYNC(n) do { if (PROBE == (n) && rep_ == 0) xcd_barrier(xbar); } while (0)
    REPEAT(1) { if (IN(0)) { TIDS phase0(a, lds, tid, lane, wave, G, bid); } RSYNC(1); }
    SEAM(0);
    REPEAT(2) { if (IN(1)) {
            unsigned* qctr = (unsigned*)a.ws + 3584 + (4 + rep_) * 64;
            volatile LAS unsigned* qw = (volatile LAS unsigned*)(lds + LDS_BYTES - 32);
#pragma unroll 1
            for (;;) { TIDS
                if (tid == 0) qw[0] = __hip_atomic_fetch_add(qctr, 1u, __ATOMIC_RELAXED, __HIP_MEMORY_SCOPE_AGENT);
                __syncthreads();
                const int item = (int)qw[0];
                __syncthreads();
                if (item >= 384 + 640) break;
                if (item < 384) ada_item(a, lds, item, tid, lane, wave);
                else transpose_wg_item(a, lds, item - 384, lane, wave);
            }
        } RSYNC(2); }
    SEAM(1);
#pragma unroll 1
    for (int l = 0; l < 2; ++l) {
        const int pb = 2 + 5 * l;
        REPEAT(3) { if (IN(pb)) { TIDS phase_norm(a, l, lds, tid, lane, wave, G, bid); } RSYNC(3); }
        SEAM(pb);
        REPEAT(4) { if (IN(pb + 1)) {
            pg8::Gemm g{(const bf16_t*)(a.ws + WS_HN), (const bf16_t*)(a.ws + WS_WIN) + (size_t)l * NB * D, MP, NB, D};
            pg8::StaticOrder S; S.init(MP, NB, G, bid);
            pg8::EpiP E{(bf16_t*)(a.ws + WS_P), NB};
            pg8::gemm_phase<pg8::EpiP, pg8::StaticOrder>(lds, g, S, E);
#pragma unroll 1
            for (int item = bid; item < 256; item += G) { TIDS skinny_item<0>(a, l, item * 32, (const bf16_t*)(a.ws + WS_HNS), (const bf16_t*)(a.ws + WS_WIN) + (size_t)l * NB * D, lds, tid, lane, wave); }
        } RSYNC(4); }
        SEAM(pb + 1);
        REPEAT(5) { if (IN(pb + 2)) {
            unsigned* qctr = (unsigned*)a.ws + 3584 + (l * 2 + rep_) * 64;
            volatile LAS unsigned* qw = (volatile LAS unsigned*)(lds + LDS_BYTES - 32);
#pragma unroll 1
            for (;;) { TIDS
                if (tid == 0) qw[0] = __hip_atomic_fetch_add(qctr, 1u, __ATOMIC_RELAXED, __HIP_MEMORY_SCOPE_AGENT);
                __syncthreads();
                const int item = (int)qw[0];
                __syncthreads();
                if (item >= 896) break;
                if (item < 128) { scan_item(a, l, item, lds, tid, lane, wave); if (PROBE == 8) scan_item(a, l, item, lds, tid, lane, wave); }
                else if (item < 384) { mix_item(a, l, item - 128, lds, tid, lane, wave); if (PROBE == 9) mix_item(a, l, item - 128, lds, tid, lane, wave); }
                else { sample_item(a, l, item - 384, lds, tid, lane, wave); if (PROBE == 10) sample_item(a, l, item - 384, lds, tid, lane, wave); }
            }
        } RSYNC(5); }
        SEAM(pb + 2);
        REPEAT(6) { if (IN(pb + 3)) {
#pragma unroll 1
            for (int item = bid; item < 320; item += G) { TIDS
                if (item < 256) mlstm_out_item(a, l, item, lds, tid, lane, wave);
                else skinny_item<1>(a, l, (item - 256) * 32, (const bf16_t*)(a.ws + WS_ACTS), (const bf16_t*)(a.ws + WS_WOUT) + (size_t)l * D * D, lds, tid, lane, wave); }
        } RSYNC(6); }
        SEAM(pb + 3);
        REPEAT(7) { if (IN(pb + 4)) {
            pg8::Gemm g{(const bf16_t*)(a.ws + WS_ACT), (const bf16_t*)(a.ws + WS_WOUT) + (size_t)l * D * D, MP, D, D};
            pg8::StaticOrder S; S.init(MP, D, G, bid);
            pg8::EpiRes E{l == 0 ? a.in[0] : (const float*)(a.ws + WS_X1), l == 0 ? a.in[1] : (const float*)(a.ws + WS_X1) + (size_t)MP * D,
                          l == 0 ? (float*)(a.ws + WS_X1) : a.out + OY, (const float*)(a.ws + WS_MOD) + (size_t)l * NCR * NMOD};
            pg8::gemm_phase<pg8::EpiRes, pg8::StaticOrder>(lds, g, S, E);
        } RSYNC(7); }
        SEAM(pb + 4);
    }
    if (IN(12)) { TIDS phase_final(a, tid, lane, wave, G, bid); }
#undef TIDS
#undef IN
#undef SEAM
}

#ifndef N_LAUNCH_MODE
#define N_LAUNCH_MODE 1
#endif

extern "C" void kernel_launch(void* const* d_in, const int* in_sizes, int n_in, void* d_out, int out_size, void* d_ws, size_t ws_size, hipStream_t stream) {
    static int grid = 0;
    if (grid == 0) {
        int dev = 0, cus = 0, per_cu = 0;
        hipGetDevice(&dev);
        hipDeviceGetAttribute(&cus, hipDeviceAttributeMultiprocessorCount, dev);
        hipFuncSetAttribute((const void*)fwd_megakernel, hipFuncAttributeMaxDynamicSharedMemorySize, LDS_BYTES);
        hipOccupancyMaxActiveBlocksPerMultiprocessor(&per_cu, (const void*)fwd_megakernel, 512, LDS_BYTES);
        if (per_cu < 1) { fprintf(stderr, "occupancy query returned %d\n", per_cu); per_cu = 1; }
        grid = cus * per_cu;
        if (n_in != 19 || ws_size < WS_END) { fprintf(stderr, "unexpected n_in %d / ws %zu\n", n_in, ws_size); }
    }
    (void)hipMemsetAsync(d_ws, 0, 16384, stream);
    Args a{};
    for (int i = 0; i < 19; ++i) a.in[i] = (const float*)d_in[i];
    a.out = (float*)d_out; a.ws = (unsigned char*)d_ws;
#if N_LAUNCH_MODE == 1
    a.ph_lo = 0; a.ph_hi = NPHASE;
    void* args[] = {&a};
    hipError_t e = hipLaunchCooperativeKernel((const void*)fwd_megakernel, dim3(grid), dim3(512), args, LDS_BYTES, stream);
    if (e != hipSuccess) fprintf(stderr, "cooperative launch failed: %s (grid %d)\n", hipGetErrorString(e), grid);
#else
    for (int p = 0; p < NPHASE; ++p) {
        a.ph_lo = p; a.ph_hi = p + 1;
        void* args[] = {&a};
        hipError_t e = hipLaunchCooperativeKernel((const void*)fwd_megakernel, dim3(grid), dim3(512), args, LDS_BYTES, stream);
        if (e != hipSuccess) { fprintf(stderr, "launch %d failed: %s (grid %d)\n", p, hipGetErrorString(e), grid); break; }
    }
#endif
}
```
